# Optimizing an MI355X kernel written in HIP

```python
import math
import jax, jax.numpy as jnp
from jax import lax
import numpy as np

D_MODEL = 2048
BATCH = 4
SEQ = 2048
DEPTH = 4
DEC_BATCH = 2
DEC_SEQ = 16384
PAST_LEN = 128

N_MIXERS = 2
N_ATTN_LAYERS = (DEPTH + 1) // 2
N_HYENA_LAYERS = DEPTH // 2
HEAD_DIM = 128
HEADS_PER_GROUP = D_MODEL // HEAD_DIM
GROUP_WINDOWS = (128, 512, 2048)
GROUP_DILATIONS = (1, 4, 16)
N_GROUPS = 3
QKV_WIDTH = N_GROUPS * 3 * HEADS_PER_GROUP * HEAD_DIM
ATTN_WIDTH = HEADS_PER_GROUP * HEAD_DIM
ROPE_THETA = 10000.0
D_FF = 4 * D_MODEL
SHORT_CONV = 3
FILTER_EMB = 33
FILTER_BANDS = (FILTER_EMB - 1) // 2
FILTER_HIDDEN = 64
DECAY_TARGET = 1e-2
FAST_DECAY_PCT = 0.3
SLOW_DECAY_PCT = 1.5
EPS = 1e-6

kernel_name = "hybrid_dilated_attn_hyena_encoder"


def rms_norm(x, g):
    xf = x.astype(jnp.float32)
    y = xf * lax.rsqrt(jnp.mean(xf * xf, axis=-1, keepdims=True) + EPS)
    return (y * g.astype(jnp.float32)).astype(x.dtype)


def rope_tables(S):
    inv = ROPE_THETA ** (-jnp.arange(0, HEAD_DIM, 2, dtype=jnp.float32) / HEAD_DIM)
    ang = jnp.arange(S, dtype=jnp.float32)[:, None] * inv[None, :]
    return jnp.cos(ang), jnp.sin(ang)


def apply_rope(t, cos, sin):
    half = HEAD_DIM // 2
    t1, t2 = t[..., :half], t[..., half:]
    c = cos[None, :, None, :]
    s = sin[None, :, None, :]
    return jnp.concatenate([t1 * c - t2 * s, t2 * c + t1 * s], axis=-1)


def dilated_window_attention(q, k, v, dilation, half):
    B, S, H, Dh = q.shape
    n = S // dilation
    nb = -(-n // half)
    L = nb * half

    def by_stride(t):
        return t.reshape(B, n, dilation, H, Dh).transpose(0, 2, 3, 1, 4)

    qb = jnp.pad(by_stride(q), ((0, 0), (0, 0), (0, 0), (0, L - n), (0, 0))).reshape(B, dilation, H, nb, half, Dh)

    def neighbours(t):
        tp = jnp.pad(by_stride(t), ((0, 0), (0, 0), (0, 0), (half, L - n + half), (0, 0))).reshape(B, dilation, H, nb + 2, half, Dh)
        return jnp.concatenate([tp[:, :, :, :-2], tp[:, :, :, 1:-1], tp[:, :, :, 2:]], axis=4)

    kb = neighbours(k)
    vb = neighbours(v)
    s = jnp.einsum('brhnqd,brhnkd->brhnqk', qb, kb)
    jq = jnp.arange(nb)[:, None] * half + jnp.arange(half)[None, :]
    jk = (jnp.arange(nb)[:, None] - 1) * half + jnp.arange(3 * half)[None, :]
    rel = jk[:, None, :] - jq[:, :, None]
    valid = (jnp.abs(rel) <= half) & (jk[:, None, :] >= 0) & (jk[:, None, :] < n)
    s = jnp.where(valid, s, -jnp.inf)
    m = jnp.max(s, axis=-1, keepdims=True)
    p = jnp.exp(s - m)
    den = jnp.sum(p, axis=-1)
    o = jnp.einsum('brhnqk,brhnkd->brhnqd', p, vb) / den[..., None]
    lse = m[..., 0] + jnp.log(den)
    o = o.reshape(B, dilation, H, L, Dh)[:, :, :, :n].transpose(0, 3, 1, 2, 4).reshape(B, S, H, Dh)
    lse = lse.reshape(B, dilation, H, L)[..., :n].transpose(0, 3, 1, 2).reshape(B, S, H)
    return o, lse


def attention_mixer(xn, w_qkv, q_gain, k_gain, w_out, cos, sin):
    B, S, _ = xn.shape
    qkv = (xn @ w_qkv).reshape(B, S, N_GROUPS, 3, HEADS_PER_GROUP, HEAD_DIM).astype(jnp.float32)
    scale = HEAD_DIM ** -0.5
    outs = []
    lses = []
    for g in range(N_GROUPS):
        q = apply_rope(rms_norm(qkv[:, :, g, 0], q_gain[g]), cos, sin) * scale
        k = apply_rope(rms_norm(qkv[:, :, g, 1], k_gain[g]), cos, sin)
        dil = GROUP_DILATIONS[g]
        o, l = dilated_window_attention(q, k, qkv[:, :, g, 2], dil, GROUP_WINDOWS[g] // (2 * dil))
        outs.append(o)
        lses.append(l)
    w = jax.nn.softmax(jnp.stack(lses), axis=0)
    o = jnp.einsum('gbsh,gbshd->bshd', w, jnp.stack(outs))
    return o.reshape(B, S, ATTN_WIDTH).astype(xn.dtype) @ w_out


def implicit_filters(L, w1, b1, w2, b2, w3, b3, freq, w4):
    f32 = jnp.float32
    pos = jnp.arange(L, dtype=f32)
    t = pos / (L - 1)
    bands = jnp.linspace(1e-4, FILTER_BANDS - 1, FILTER_BANDS, dtype=f32)
    ang = (2.0 * math.pi / L) * pos[:, None] * bands[None, :]
    z = jnp.concatenate([t[:, None], jnp.cos(ang), -jnp.sin(ang)], axis=-1)
    fr = freq.astype(f32)
    h = jnp.sin(fr * (z @ w1.astype(f32) + b1.astype(f32)))
    h = jnp.sin(fr * (h @ w2.astype(f32) + b2.astype(f32)))
    h = jnp.sin(fr * (h @ w3.astype(f32) + b3.astype(f32)))
    h = h @ w4.astype(f32)
    deltas = jnp.abs(jnp.linspace(math.log(DECAY_TARGET) / SLOW_DECAY_PCT, math.log(DECAY_TARGET) / FAST_DECAY_PCT, D_MODEL, dtype=f32))
    decay = jnp.exp(-t[:, None] * deltas[None, :])
    return h[:, :D_MODEL] * decay, h[:, D_MODEL:] * decay


def bidirectional_long_conv(z, h_fwd, h_bwd):
    L = z.shape[1]
    kern = jnp.concatenate([h_fwd, jnp.zeros((1, D_MODEL), jnp.float32), h_bwd[1:][::-1]], axis=0)
    zf = jnp.fft.rfft(z, n=2 * L, axis=1)
    kf = jnp.fft.rfft(kern, axis=0)
    return jnp.fft.irfft(zf * kf[None], n=2 * L, axis=1)[:, :L]


def hyena_mixer(xn, w_in, b_in, conv_w, conv_b, fw1, fb1, fw2, fb2, fw3, fb3, ffreq, fw4, skip, w_out, b_out):
    B, L, _ = xn.shape
    u = xn @ w_in + b_in
    up = jnp.pad(u, ((0, 0), (1, 1), (0, 0)))
    u = up[:, :-2] * conv_w[0] + up[:, 1:-1] * conv_w[1] + up[:, 2:] * conv_w[2] + conv_b
    x0, x1, v = jnp.split(u.astype(jnp.float32), 3, axis=-1)
    h_fwd, h_bwd = implicit_filters(L, fw1, fb1, fw2, fb2, fw3, fb3, ffreq, fw4)
    z = v * x1
    z = bidirectional_long_conv(z, h_fwd, h_bwd) + z * skip.astype(jnp.float32)
    y = (z * x0).astype(xn.dtype)
    return y @ w_out + b_out


def squared_relu_mlp(xn, w1, w2):
    h = jax.nn.relu(xn @ w1)
    return (h * h) @ w2


def trunk(x, mix_norm, mlp_norm, attn_w_qkv, attn_q_gain, attn_k_gain, attn_w_out,
          hy_w_in, hy_b_in, hy_conv_w, hy_conv_b, hy_filt_w1, hy_filt_b1, hy_filt_w2, hy_filt_b2,
          hy_filt_w3, hy_filt_b3, hy_filt_freq, hy_filt_w4, hy_skip, hy_w_out, hy_b_out, mlp_w1, mlp_w2):
    cos, sin = rope_tables(x.shape[1])
    for i in range(DEPTH):
        xn = rms_norm(x, mix_norm[i])
        j = i // N_MIXERS
        if i % N_MIXERS == 0:
            x = x + attention_mixer(xn, attn_w_qkv[j], attn_q_gain[j], attn_k_gain[j], attn_w_out[j], cos, sin)
        else:
            x = x + hyena_mixer(xn, hy_w_in[j], hy_b_in[j], hy_conv_w[j], hy_conv_b[j],
                                hy_filt_w1[j], hy_filt_b1[j], hy_filt_w2[j], hy_filt_b2[j],
                                hy_filt_w3[j], hy_filt_b3[j], hy_filt_freq[j], hy_filt_w4[j],
                                hy_skip[j], hy_w_out[j], hy_b_out[j])
        x = x + squared_relu_mlp(rms_norm(x, mlp_norm[i]), mlp_w1[i], mlp_w2[i])
    return x


def setup_inputs(seed: int = 0) -> dict:
    key = jax.random.key(seed)
    ks = jax.random.split(key, 26)

    def nrm(k, shape, scale):
        return jax.random.normal(k, shape, jnp.float32) * scale

    D = D_MODEL
    NA = N_ATTN_LAYERS
    NH = N_HYENA_LAYERS
    FH = FILTER_HIDDEN
    return {
        "x_prompt": nrm(ks[0], (BATCH, SEQ, D), 1.0),
        "x_sample": nrm(ks[1], (DEC_BATCH, DEC_SEQ, D), 1.0),
        "mix_norm": 1.0 + nrm(ks[2], (DEPTH, D), 0.02),
        "mlp_norm": 1.0 + nrm(ks[3], (DEPTH, D), 0.02),
        "attn_w_qkv": nrm(ks[4], (NA, D, QKV_WIDTH), D ** -0.5),
        "attn_q_gain": 1.0 + nrm(ks[5], (NA, N_GROUPS, HEAD_DIM), 0.02),
        "attn_k_gain": 1.0 + nrm(ks[6], (NA, N_GROUPS, HEAD_DIM), 0.02),
        "attn_w_out": nrm(ks[7], (NA, ATTN_WIDTH, D), ATTN_WIDTH ** -0.5),
        "hy_w_in": nrm(ks[8], (NH, D, 3 * D), D ** -0.5),
        "hy_b_in": nrm(ks[9], (NH, 3 * D), 0.02),
        "hy_conv_w": nrm(ks[10], (NH, SHORT_CONV, 3 * D), 0.5),
        "hy_conv_b": nrm(ks[11], (NH, 3 * D), 0.02),
        "hy_filt_w1": nrm(ks[12], (NH, FILTER_EMB, FH), FILTER_EMB ** -0.5),
        "hy_filt_b1": nrm(ks[13], (NH, FH), 0.02),
        "hy_filt_w2": nrm(ks[14], (NH, FH, FH), FH ** -0.5),
        "hy_filt_b2": nrm(ks[15], (NH, FH), 0.02),
        "hy_filt_w3": nrm(ks[16], (NH, FH, FH), FH ** -0.5),
        "hy_filt_b3": nrm(ks[17], (NH, FH), 0.02),
        "hy_filt_freq": 1.0 + nrm(ks[18], (NH, FH), 0.02),
        "hy_filt_w4": nrm(ks[19], (NH, FH, 2 * D), 0.03 * FH ** -0.5),
        "hy_skip": nrm(ks[20], (NH, D), 0.5),
        "hy_w_out": nrm(ks[21], (NH, D, D), D ** -0.5),
        "hy_b_out": nrm(ks[22], (NH, D), 0.02),
        "mlp_w1": nrm(ks[23], (DEPTH, D, D_FF), D ** -0.5),
        "mlp_w2": nrm(ks[24], (DEPTH, D_FF, D), D_FF ** -0.5),
    }


def reference(x_prompt, x_sample, mix_norm, mlp_norm, attn_w_qkv, attn_q_gain, attn_k_gain, attn_w_out,
              hy_w_in, hy_b_in, hy_conv_w, hy_conv_b, hy_filt_w1, hy_filt_b1, hy_filt_w2, hy_filt_b2,
              hy_filt_w3, hy_filt_b3, hy_filt_freq, hy_filt_w4, hy_skip, hy_w_out, hy_b_out, mlp_w1, mlp_w2):
    weights = (mix_norm, mlp_norm, attn_w_qkv, attn_q_gain, attn_k_gain, attn_w_out,
               hy_w_in, hy_b_in, hy_conv_w, hy_conv_b, hy_filt_w1, hy_filt_b1, hy_filt_w2, hy_filt_b2,
               hy_filt_w3, hy_filt_b3, hy_filt_freq, hy_filt_w4, hy_skip, hy_w_out, hy_b_out, mlp_w1, mlp_w2)
    y_prompt = trunk(x_prompt, *weights)
    y_sample = trunk(x_sample, *weights)
    return (y_prompt, y_sample)
```

```cpp
#include <hip/hip_runtime.h>
#include <cstdio>
#include <cstdint>
#include <cmath>
namespace pg8 {
#define PG8_LAS __attribute__((address_space(3)))
typedef unsigned short bf16_t;
typedef short bf16x8 __attribute__((ext_vector_type(8)));
typedef float f32x4 __attribute__((ext_vector_type(4)));
typedef unsigned u32x4 __attribute__((ext_vector_type(4)));
constexpr int BM = 256, BK = 64, HALF = 128, HTB = HALF * BK * 2  , STAGE_BYTES = 8 * HTB, NXCD = 8, WGM = 4;

__host__ __device__ __forceinline__ int lds_byte(int r, int c) { const int st = (r >> 4) * 2 + (c >> 5), rr = r & 15, cc = c & 31, ob = rr * 64 + cc * 2; return st * 1024 + (ob ^ (((ob >> 9) & 1) << 5)); }
__host__ __device__ __forceinline__ void stage_rc(int b, int& R, int& C) { const int st = b / 1024, sb = b % 1024, swz = sb ^ (((sb >> 9) & 1) << 5); R = (st >> 1) * 16 + swz / 64; C = (st & 1) * 32 + (swz % 64) / 2; }
__host__ __device__ __forceinline__ int perm32(int rho) { const int n = rho >> 4, i = rho & 15; return 8 * (i >> 2) + 4 * n + (i & 3); }

struct Unit { int pm, pn; };
struct Gemm { const bf16_t* A; const bf16_t* Bt; int M, N, K; };

struct StaticOrder {
    int nM, nN, nwg, G, c;
    __host__ __device__ void init(int M, int N, int G_, int c_) { nM = M / BM; nN = N / BM; nwg = nM * nN; G = G_; c = c_; }
    __host__ __device__ bool next(int i, Unit& u) const {
        const long L = (long)i * G + c; if (L >= nwg) return false;
        int wgid = (int)L; { const int q = nwg / NXCD, r = nwg % NXCD, xcd = wgid % NXCD, off = wgid / NXCD; wgid = (xcd < r ? xcd * (q + 1) : r * (q + 1) + (xcd - r) * q) + off; }
        const int nig = WGM * nN, gid = wgid / nig, fm = gid * WGM, gsz = (nM - fm) < WGM ? (nM - fm) : WGM;
        u.pm = fm + ((wgid % nig) % gsz); u.pn = (wgid % nig) / gsz; return true;
    }
    __device__ __forceinline__ void a_ready(const Unit&, int, int, int) const {}
    __device__ __forceinline__ void done(const Unit&) const {}
};

struct NormOrder : StaticOrder {
    const float* ss; PG8_LAS unsigned char* tbl;
    __device__ __forceinline__ void a_ready(const Unit& u, int ui, int wid, int lane) const {
        __builtin_amdgcn_global_load_lds((const unsigned*)(ss + ((size_t)u.pm * BM + wid * 32) * 8 + lane * 4), (PG8_LAS unsigned*)(tbl + (ui & 1) * 8192 + wid * 1024), 16, 0, 0);
    }
};
__device__ __forceinline__ unsigned cvt_pk_bf16(float lo, float hi) { unsigned r; asm volatile("v_cvt_pk_bf16_f32 %0, %1, %2" : "=v"(r) : "v"(lo), "v"(hi)); return r; }
typedef float f32x2 __attribute__((ext_vector_type(2)));
__device__ __forceinline__ f32x2 gelu_pk(f32x2 v) {
    const f32x2 av = __builtin_elementwise_abs(v), d = av * 0.2316418882f + 1.0f;
    f32x2 t; t.x = __builtin_amdgcn_rcpf(d.x); t.y = __builtin_amdgcn_rcpf(d.y);
    f32x2 q = t * 0.5307027145f + (-0.7265760135f); q = q * t + 0.7107068705f; q = q * t + (-0.142248368f); q = q * t + 0.127414796f; q = q * t;
    const f32x2 s = (v * v) * (-0.72134752044f);
    f32x2 e; e.x = __builtin_amdgcn_exp2f(s.x); e.y = __builtin_amdgcn_exp2f(s.y);
    const f32x2 m = v * (q * e), r = v - m;
    f32x2 o; o.x = v.x < 0.f ? m.x : r.x; o.y = v.y < 0.f ? m.y : r.y; return o;
}


template <int ACT  > struct EpiBf16 {
    static constexpr bool PERM = true, AFTER_DRAIN = false;
    bf16_t* O; int ldc; const float* bias; const PG8_LAS unsigned char* tbl; int qk_hc; const float* qg; const float* kg; PG8_LAS float* xq; int mp, lpm, lsm;
    __device__ __forceinline__ void operator()(const f32x4 (&acc)[2][2][4][2], const Unit& u, int ui, int wr, int wc, int fr, int fq) const {
        const int row0 = u.pm * BM + wr * 64 + fr; const int col0 = u.pn * BM + wc * 32 + 8 * fq;
        f32x4 bv[2][2];
#pragma unroll
        for (int bj = 0; bj < 2; ++bj)
#pragma unroll
            for (int n = 0; n < 2; ++n) bv[bj][n] = bias ? *(const f32x4*)(bias + col0 + bj * HALF + 4 * n) : (f32x4){0.f, 0.f, 0.f, 0.f};
        float rs[2][4];
#pragma unroll
        for (int ai = 0; ai < 2; ++ai)
#pragma unroll
            for (int m = 0; m < 4; ++m) { float tot = 2048.0f; if (tbl) { const PG8_LAS f32x4* tp = (const PG8_LAS f32x4*)(tbl + (ui & 1) * 8192 + (ai * HALF + wr * 64 + m * 16 + fr) * 32); const f32x4 p0 = tp[0], p1 = tp[1]; tot = ((p0[0] + p0[1]) + (p0[2] + p0[3])) + ((p1[0] + p1[1]) + (p1[2] + p1[3])); }
                rs[ai][m] = tbl ? 1.0f / sqrtf(tot * (1.0f / 2048.0f) + 1e-6f) : 1.0f; }
        int kind = 2, grp = 0;
        if (qk_hc > 0) { const int gt = (2 * u.pn) / qk_hc; kind = gt % 3; grp = gt / 3; }
        const bool qk = kind != 2;
        const int lane = fq * 16 + fr;
        f32x4 glo = {1.f, 1.f, 1.f, 1.f}, ghi = glo; float inv[4] = {0.f, 0.f, 0.f, 0.f};
        if (qk) {
#pragma unroll
            for (int ai = 0; ai < 2; ++ai)
#pragma unroll
                for (int m = 0; m < 4; ++m)
#pragma unroll
                    for (int bj = 0; bj < 2; ++bj) { const f32x4 a = acc[ai][bj][m][0] * rs[ai][m], b = acc[ai][bj][m][1] * rs[ai][m];
                        float sq = ((a[0] * a[0] + a[1] * a[1]) + (a[2] * a[2] + a[3] * a[3])) + ((b[0] * b[0] + b[1] * b[1]) + (b[2] * b[2] + b[3] * b[3]));
                        sq += __builtin_bit_cast(float, __builtin_amdgcn_ds_bpermute((lane ^ 16) << 2, __builtin_bit_cast(int, sq)));
                        sq += __builtin_bit_cast(float, __builtin_amdgcn_ds_bpermute((lane ^ 32) << 2, __builtin_bit_cast(int, sq)));
                        if (fq == 0) xq[((ai * HALF + wr * 64 + m * 16 + fr) * 2 + bj) * 4 + wc] = sq; }
            const float* gp = (kind == 0 ? qg : kg) + grp * 128 + 16 * wc + 4 * fq;
            glo = *(const f32x4*)gp; ghi = *(const f32x4*)(gp + 64);
#pragma unroll
            for (int e = 0; e < 4; ++e) inv[e] = __builtin_amdgcn_exp2f(-(float)(16 * wc + 4 * fq + e) * (13.287712379549449f / 64.0f));
            asm volatile("s_waitcnt lgkmcnt(0)" ::: "memory"); __builtin_amdgcn_s_barrier(); asm volatile("" ::: "memory");
        }
        const float qsc = kind == 0 ? 0.08838834764831845f * 1.4426950408889634f : 1.0f;
#pragma unroll
        for (int ai = 0; ai < 2; ++ai)
#pragma unroll
            for (int m = 0; m < 4; ++m) { const int row = row0 + ai * HALF + m * 16; bf16_t* rowp = O + (size_t)row * ldc + col0; const float sc = rs[ai][m];
                float cs[4] = {1.f, 1.f, 1.f, 1.f}, sn[4] = {0.f, 0.f, 0.f, 0.f};
                if (qk) { const float pos = (float)(row < mp ? (row & lpm) : ((row - mp) & lsm));
#pragma unroll
                    for (int e = 0; e < 4; ++e) { float rev = pos * inv[e] * 0.15915494309189535f; rev -= __builtin_floorf(rev); cs[e] = __builtin_amdgcn_cosf(rev); sn[e] = __builtin_amdgcn_sinf(rev); } }
#pragma unroll
                for (int bj = 0; bj < 2; ++bj) { f32x4 v0 = acc[ai][bj][m][0] * sc + bv[bj][0], v1 = acc[ai][bj][m][1] * sc + bv[bj][1];
                    if (ACT == 3) {
#pragma unroll
                        for (int j = 0; j < 4; ++j) { const float a = fmaxf(v0[j], 0.f), b = fmaxf(v1[j], 0.f); v0[j] = a * a; v1[j] = b * b; } }
                    if (qk) { const f32x4 pt = *(const PG8_LAS f32x4*)(xq + ((ai * HALF + wr * 64 + m * 16 + fr) * 2 + bj) * 4);
                        const float r = qsc / sqrtf(((pt[0] + pt[1]) + (pt[2] + pt[3])) * (1.0f / 128.0f) + 1e-6f);
#pragma unroll
                        for (int e = 0; e < 4; ++e) { const float y0 = v0[e] * r * glo[e], y1 = v1[e] * r * ghi[e]; v0[e] = y0 * cs[e] - y1 * sn[e]; v1[e] = y1 * cs[e] + y0 * sn[e]; } }
                    u32x4 w; w.x = cvt_pk_bf16(v0[0], v0[1]); w.y = cvt_pk_bf16(v0[2], v0[3]); w.z = cvt_pk_bf16(v1[0], v1[1]); w.w = cvt_pk_bf16(v1[2], v1[3]);
                    *(u32x4*)(rowp + bj * HALF) = w; } }
    }
};
struct EpiResF32 {
    static constexpr bool PERM = true, AFTER_DRAIN = false;
    float* C; int ldc; const float* bias; bf16_t* XB; float* SS; PG8_LAS float* xl;
    const float* Cin0; const float* Cin1; int msplit;
    __device__ __forceinline__ void operator()(const f32x4 (&acc)[2][2][4][2], const Unit& u, int  , int wr, int wc, int fr_, int fq_) const {
        int fr = fr_, fq = fq_; asm volatile("" : "+v"(fr), "+v"(fq));
        const int row0 = u.pm * BM + wr * 64 + fr, col0 = u.pn * BM + wc * 32 + 8 * fq;
        f32x4 bv[2][2];
#pragma unroll
        for (int bj = 0; bj < 2; ++bj)
#pragma unroll
            for (int n = 0; n < 2; ++n) bv[bj][n] = bias ? *(const f32x4*)(bias + col0 + bj * HALF + n * 4) : (f32x4){0.f, 0.f, 0.f, 0.f};
        const int lane = fq * 16 + fr;
#pragma unroll
        for (int ai = 0; ai < 2; ++ai) {
            f32x4 r[4][2][2];
#pragma unroll
            for (int m = 0; m < 4; ++m) { const int rr_ = row0 + ai * HALF + m * 16; const float* rowp = (rr_ < msplit ? Cin0 + (size_t)rr_ * ldc : Cin1 + (size_t)(rr_ - msplit) * ldc) + col0;
#pragma unroll
                for (int bj = 0; bj < 2; ++bj)
#pragma unroll
                    for (int n = 0; n < 2; ++n) r[m][bj][n] = *(const f32x4*)(rowp + bj * HALF + n * 4); }
#pragma unroll
            for (int m = 0; m < 4; ++m) { const int row = row0 + ai * HALF + m * 16; float* rowp = C + (size_t)row * ldc + col0; bf16_t* xbp = XB + (size_t)row * ldc + col0;
                float sq = 0.f;
#pragma unroll
                for (int bj = 0; bj < 2; ++bj) { const f32x4 v0 = r[m][bj][0] + acc[ai][bj][m][0] + bv[bj][0], v1 = r[m][bj][1] + acc[ai][bj][m][1] + bv[bj][1];
                    *(f32x4*)(rowp + bj * HALF) = v0; *(f32x4*)(rowp + bj * HALF + 4) = v1;
                    u32x4 w; w.x = cvt_pk_bf16(v0[0], v0[1]); w.y = cvt_pk_bf16(v0[2], v0[3]); w.z = cvt_pk_bf16(v1[0], v1[1]); w.w = cvt_pk_bf16(v1[2], v1[3]); *(u32x4*)(xbp + bj * HALF) = w;
                    sq += ((v0[0] * v0[0] + v0[1] * v0[1]) + (v0[2] * v0[2] + v0[3] * v0[3])) + ((v1[0] * v1[0] + v1[1] * v1[1]) + (v1[2] * v1[2] + v1[3] * v1[3])); }
                sq += __builtin_bit_cast(float, __builtin_amdgcn_ds_bpermute((lane ^ 16) << 2, __builtin_bit_cast(int, sq)));
                sq += __builtin_bit_cast(float, __builtin_amdgcn_ds_bpermute((lane ^ 32) << 2, __builtin_bit_cast(int, sq)));
                if (fq == 0) xl[(ai * HALF + wr * 64 + m * 16 + fr) * 4 + wc] = sq; }
            asm volatile("" ::: "memory"); }
        asm volatile("s_waitcnt lgkmcnt(0)" ::: "memory"); __builtin_amdgcn_s_barrier(); asm volatile("" ::: "memory");
        { int t = (wr * 4 + wc) * 64 + lane; asm volatile("" : "+v"(t));
          if (t < BM) { const f32x4 q = *(const PG8_LAS f32x4*)(xl + t * 4); SS[(size_t)(u.pm * BM + t) * 8 + u.pn] = (q[0] + q[1]) + (q[2] + q[3]); } }
        asm volatile("s_waitcnt lgkmcnt(0)" ::: "memory"); __builtin_amdgcn_s_barrier(); asm volatile("" ::: "memory");
    }
};

template <class Epi, class Sched, bool ALIGN_EPI = false, bool SP2 = false>
__device__ __forceinline__ void gemm_phase(PG8_LAS unsigned char* lds, const Gemm g, const Sched& S, const Epi& E) {
    int tid_o = threadIdx.x; asm volatile("" : "+v"(tid_o));
    const int tid = tid_o, wid = __builtin_amdgcn_readfirstlane(tid >> 6), lane = tid & 63, wr = wid >> 2, wc = wid & 3, fr = lane & 15, fq = lane >> 4;
    const int K = g.K, nt = K / BK;
    unsigned voffA[2], voffB[2];
#pragma unroll
    for (int i = 0; i < 2; ++i) { int R, C; stage_rc(tid * 16 + i * 8192, R, C); const int Rb = Epi::PERM ? ((R & ~31) + perm32(R & 31)) : R;
        voffA[i] = (unsigned)(R * K + C) * 2u; voffB[i] = (unsigned)(Rb * K + C) * 2u; }
    const size_t kstep = (size_t)(BK * 2);
    const size_t hstep = (size_t)HALF * K * 2;
    const size_t tstep = 2 * hstep;
    const unsigned ldsw = (unsigned)wid * 1024u;
    const int aoff = lds_byte(wr * 64 + fr, fq * 8), boff = lds_byte(wc * 32 + fr, fq * 8);
#define PG8_SA(b, h) (((b) * 2 + (h)) * HTB)
#define PG8_SB(b, h) ((4 + (b) * 2 + (h)) * HTB)
#define PG8_STAGE(bufoff, gbase, voff) do { _Pragma("unroll") for (int _i = 0; _i < 2; ++_i) \
        __builtin_amdgcn_global_load_lds((const unsigned*)((const char*)(gbase) + (voff)[_i]), (PG8_LAS unsigned*)(lds + (bufoff) + ldsw + _i * 8192), 16, 0, 0); } while (0)
#define PG8_LDA(dst, b, h) do { _Pragma("unroll") for (int m = 0; m < 4; ++m) _Pragma("unroll") for (int k = 0; k < 2; ++k) dst[m][k] = *(const PG8_LAS bf16x8*)(lds + PG8_SA(b, h) + aoff + m * 2048 + k * 1024); } while (0)
#define PG8_LDB(dst, b, h) do { _Pragma("unroll") for (int n = 0; n < 2; ++n) _Pragma("unroll") for (int k = 0; k < 2; ++k) dst[n][k] = *(const PG8_LAS bf16x8*)(lds + PG8_SB(b, h) + boff + n * 2048 + k * 1024); } while (0)
#define PG8_MMA(ai, bj, At, Bt) do { __builtin_amdgcn_s_setprio(1); _Pragma("unroll") for (int m = 0; m < 4; ++m) _Pragma("unroll") for (int n = 0; n < 2; ++n) _Pragma("unroll") for (int k = 0; k < 2; ++k) \
        acc[ai][bj][m][n] = __builtin_amdgcn_mfma_f32_16x16x32_bf16(Bt[n][k], At[m][k], acc[ai][bj][m][n], 0, 0, 0); __builtin_amdgcn_s_setprio(0); } while (0)
#define PG8_WAIT_V(n) asm volatile("s_waitcnt vmcnt(" #n ")" ::: "memory")
#define PG8_WAIT_L(n) asm volatile("s_waitcnt lgkmcnt(" #n ")" ::: "memory")
#define PG8_BAR __builtin_amdgcn_s_barrier()
#define PG8_SCHED __builtin_amdgcn_sched_barrier(0)
    Unit cur, nxt; int ui = 0;
    if (!S.next(0, cur)) return;
    f32x4 acc[2][2][4][2];
#pragma unroll
    for (int a = 0; a < 2; ++a)
#pragma unroll
        for (int b = 0; b < 2; ++b)
#pragma unroll
            for (int m = 0; m < 4; ++m)
#pragma unroll
                for (int n = 0; n < 2; ++n) acc[a][b][m][n] = (f32x4){0.f, 0.f, 0.f, 0.f};
    bf16x8 At[4][2], B0[2][2], B1[2][2];
    const char* cA = (const char*)g.A + (size_t)cur.pm * tstep; const char* cB = (const char*)g.Bt + (size_t)cur.pn * tstep;
    S.a_ready(cur, 0, wid, lane);
    if constexpr (SP2) {
        PG8_STAGE(PG8_SB(0, 0), cB, voffB); PG8_STAGE(PG8_SB(0, 1), cB + hstep, voffB); PG8_STAGE(PG8_SA(0, 0), cA, voffA); PG8_STAGE(PG8_SA(0, 1), cA + hstep, voffA);
        if (wr == 1) PG8_BAR;
        PG8_WAIT_V(2); PG8_BAR;
        PG8_STAGE(PG8_SB(1, 0), cB + kstep, voffB); PG8_STAGE(PG8_SA(1, 0), cA + kstep, voffA); PG8_STAGE(PG8_SB(1, 1), cB + hstep + kstep, voffB);
        PG8_WAIT_V(6); PG8_BAR;
    } else {
        PG8_STAGE(PG8_SB(0, 0), cB, voffB); PG8_STAGE(PG8_SA(0, 0), cA, voffA); PG8_STAGE(PG8_SB(0, 1), cB + hstep, voffB); PG8_STAGE(PG8_SA(0, 1), cA + hstep, voffA);
        if (wr == 1) PG8_BAR;
        PG8_WAIT_V(4); PG8_BAR;
        PG8_STAGE(PG8_SB(1, 0), cB + kstep, voffB); PG8_STAGE(PG8_SA(1, 0), cA + kstep, voffA); PG8_STAGE(PG8_SB(1, 1), cB + hstep + kstep, voffB);
        PG8_WAIT_V(6); PG8_BAR;
    }
    for (;;) {
        const bool has_next = S.next(ui + 1, nxt);
        const char* nA = has_next ? (const char*)g.A + (size_t)nxt.pm * tstep : cA; const char* nB = has_next ? (const char*)g.Bt + (size_t)nxt.pn * tstep : cB;
        for (int t = 0; t < nt; t += 2) {
            const bool last = (t == nt - 2);
            const char* a1 = cA + (size_t)(t + 1) * kstep;
            const char* a2 = last ? nA : cA + (size_t)(t + 2) * kstep; const char* b2 = last ? nB : cB + (size_t)(t + 2) * kstep;
            const char* a3 = a2 + kstep; const char* b3 = b2 + kstep;
            if (last && has_next) S.a_ready(nxt, ui + 1, wid, lane);
            if constexpr (SP2) {
            PG8_LDB(B0, 0, 0); PG8_LDB(B1, 0, 1); PG8_SCHED; PG8_LDA(At, 0, 0); PG8_STAGE(PG8_SA(1, 1), a1 + hstep, voffA);
            PG8_WAIT_V(8); PG8_WAIT_L(0); PG8_BAR; PG8_MMA(0, 0, At, B0); PG8_MMA(0, 1, At, B1); PG8_BAR; PG8_SCHED;
            PG8_LDA(At, 0, 1); PG8_STAGE(PG8_SB(0, 0), b2, voffB); PG8_STAGE(PG8_SB(0, 1), b2 + hstep, voffB); PG8_STAGE(PG8_SA(0, 0), a2, voffA);
            PG8_WAIT_V(8); PG8_WAIT_L(0); PG8_BAR; PG8_MMA(1, 0, At, B0); PG8_MMA(1, 1, At, B1); PG8_BAR; PG8_SCHED;
            PG8_LDB(B0, 1, 0); PG8_LDB(B1, 1, 1); PG8_SCHED; PG8_LDA(At, 1, 0); PG8_STAGE(PG8_SA(0, 1), a2 + hstep, voffA);
            PG8_WAIT_V(8); PG8_WAIT_L(0); PG8_BAR; PG8_MMA(0, 0, At, B0); PG8_MMA(0, 1, At, B1); PG8_BAR; PG8_SCHED;
            PG8_LDA(At, 1, 1); PG8_STAGE(PG8_SB(1, 0), b3, voffB); PG8_STAGE(PG8_SB(1, 1), b3 + hstep, voffB); PG8_STAGE(PG8_SA(1, 0), a3, voffA);
            PG8_WAIT_V(8); PG8_WAIT_L(0); PG8_BAR; PG8_MMA(1, 0, At, B0); PG8_MMA(1, 1, At, B1); PG8_BAR; PG8_SCHED;
            } else {
            PG8_LDB(B0, 0, 0); PG8_SCHED; PG8_LDA(At, 0, 0); PG8_STAGE(PG8_SA(1, 1), a1 + hstep, voffA);
            PG8_WAIT_L(8); PG8_BAR; PG8_WAIT_L(0); PG8_MMA(0, 0, At, B0); PG8_BAR; PG8_SCHED;
            PG8_LDB(B1, 0, 1); PG8_STAGE(PG8_SB(0, 0), b2, voffB);
            PG8_BAR; PG8_WAIT_L(0); PG8_MMA(0, 1, At, B1); PG8_BAR;
            PG8_LDA(At, 0, 1); PG8_STAGE(PG8_SA(0, 0), a2, voffA);
            PG8_BAR; PG8_WAIT_L(0); PG8_MMA(1, 0, At, B0); PG8_BAR; PG8_SCHED;
            PG8_STAGE(PG8_SB(0, 1), b2 + hstep, voffB);
            PG8_WAIT_V(6); PG8_BAR; PG8_MMA(1, 1, At, B1); PG8_BAR;
            PG8_LDB(B0, 1, 0); PG8_SCHED; PG8_LDA(At, 1, 0); PG8_STAGE(PG8_SA(0, 1), a2 + hstep, voffA);
            PG8_WAIT_L(8); PG8_BAR; PG8_WAIT_L(0); PG8_MMA(0, 0, At, B0); PG8_BAR; PG8_SCHED;
            PG8_LDB(B1, 1, 1); PG8_STAGE(PG8_SB(1, 0), b3, voffB);
            PG8_BAR; PG8_WAIT_L(0); PG8_MMA(0, 1, At, B1); PG8_BAR;
            PG8_LDA(At, 1, 1); PG8_STAGE(PG8_SA(1, 0), a3, voffA);
            PG8_BAR; PG8_WAIT_L(0); PG8_MMA(1, 0, At, B0); PG8_BAR; PG8_SCHED;
            PG8_STAGE(PG8_SB(1, 1), b3 + hstep, voffB);
            PG8_WAIT_V(6); PG8_BAR; PG8_MMA(1, 1, At, B1); PG8_BAR;
            }
        }
        if constexpr (ALIGN_EPI) { if (wr == 0) PG8_BAR; }
        if constexpr (!Epi::AFTER_DRAIN) { E(acc, cur, ui, wr, wc, fr, fq); S.done(cur); }
        if (!has_next) break;
#pragma unroll
        for (int a = 0; a < 2; ++a)
#pragma unroll
            for (int b = 0; b < 2; ++b)
#pragma unroll
                for (int m = 0; m < 4; ++m)
#pragma unroll
                    for (int n = 0; n < 2; ++n) acc[a][b][m][n] = (f32x4){0.f, 0.f, 0.f, 0.f};
        cur = nxt; cA = nA; cB = nB; ++ui;
        if constexpr (ALIGN_EPI) { if (wr == 1) PG8_BAR; }
    }
    PG8_WAIT_V(0);
    if constexpr (!ALIGN_EPI) { if (wr == 0) PG8_BAR; }
    PG8_BAR;
    if constexpr (Epi::AFTER_DRAIN) { E.fused(acc, cur, wr, wc, fr, fq, lds, wid, lane); S.done(cur); }
#undef PG8_SA
#undef PG8_SB
#undef PG8_STAGE
#undef PG8_LDA
#undef PG8_LDB
#undef PG8_MMA
#undef PG8_WAIT_V
#undef PG8_WAIT_L
#undef PG8_BAR
#undef PG8_SCHED
}
}

constexpr int D = 2048, MP = 8192, MS = 32768, M = MP + MS, DFF = 8192, DEPTH = 4;
constexpr int LP = 2048, LS = 16384;
constexpr int QKVW = 18432, HD = 128;
#ifndef MK_HC
#define MK_HC 8
#endif
constexpr int HC = MK_HC, NHC = 16 / HC, QCW = 9 * HD * HC;
#ifndef MK_NCH
#define MK_NCH 2
#endif
constexpr int NCH = MK_NCH, CCH = D / NCH, UCW = 3 * CCH;
constexpr int MLPC = 8192, NMLPC = M / MLPC;
constexpr int NPOS = LP + LS;
constexpr int PPOS = 2 * LP + LS;
constexpr int NWAVES = 8, NTHR = 512;
constexpr float RMS_EPS = 1e-6f;

constexpr size_t MiB = 1u << 20;
constexpr size_t WS_CTL = 0, CTL_ZERO_BYTES = 1 * MiB;
constexpr size_t WS_H3 = 1 * MiB;
constexpr size_t WS_LSE = 7 * MiB;
constexpr size_t WS_BIASP = 6 * MiB;
constexpr size_t WS_SSA = 75 * MiB, WS_SSB = 77 * MiB;
constexpr size_t WS_FSCR = 11 * MiB;
constexpr size_t WS_WB = 79 * MiB;
constexpr size_t WB_QKV = 0, WB_OUT = 72 * MiB, WB_W1 = 80 * MiB, WB_W2 = 112 * MiB;
constexpr size_t WS_XN = 223 * MiB;
constexpr size_t WS_AO = 383 * MiB;
constexpr size_t WS_BIG = 543 * MiB;
constexpr size_t BIG_QKV = 0;
#ifndef MK_OG_INPLACE
#define MK_OG_INPLACE 1
#endif
constexpr size_t BIG_OG = MK_OG_INPLACE ? 0 : (size_t)M * QCW * 2;
constexpr size_t QKV_BYTES = (size_t)M * QCW * 2 + (MK_OG_INPLACE ? 0 : (size_t)3 * M * HC * HD * 2);
constexpr size_t BIG_U = 0;
constexpr size_t BIG_HT = BIG_U + (size_t)M * UCW * 2;
constexpr size_t BIG_ZC = BIG_HT + (size_t)CCH * 2 * NPOS * 4;
constexpr size_t BIG_X0C = BIG_ZC + (size_t)CCH * PPOS * 4;
constexpr size_t BIG_YC = BIG_X0C + (size_t)CCH * PPOS * 4;
constexpr size_t HY_BYTES = BIG_YC + (size_t)CCH * PPOS * 4;
constexpr size_t BIG_H = 0, H_BYTES = (size_t)MLPC * DFF * 2;
constexpr size_t BIG_BYTES = QKV_BYTES > HY_BYTES ? (QKV_BYTES > 2 * H_BYTES ? QKV_BYTES : 2 * H_BYTES) : (HY_BYTES > 2 * H_BYTES ? HY_BYTES : 2 * H_BYTES);
constexpr size_t WS_END = WS_BIG + BIG_BYTES;
static_assert((size_t)3 * M * HC * 4 <= 4 * MiB && WS_FSCR + 64 * MiB <= WS_SSA && (size_t)M * 8 * 4 <= 2 * MiB && WS_SSB + 2 * MiB <= WS_WB && WS_WB + 144 * MiB <= WS_XN && WS_XN + 160 * MiB <= WS_AO && WS_AO + 160 * MiB <= WS_BIG && BIG_HT % 256 == 0 && BIG_ZC % 256 == 0, "d_ws map");
constexpr int CW_BAR = 4096;

constexpr int RING_BYTES = 131072;
constexpr int SCRATCH_BYTES = 159744;
constexpr int LDSCTL_OFF = SCRATCH_BYTES, MISC_OFF = LDSCTL_OFF + 320, PTAB_OFF = LDSCTL_OFF + 512;
constexpr int LDS_BYTES = 160 * 1024;

#define GAS __attribute__((address_space(1)))
#define LAS __attribute__((address_space(3)))
#define DI __device__ __forceinline__
typedef unsigned short bf16;
typedef unsigned v4u __attribute__((ext_vector_type(4)));
typedef unsigned v2u __attribute__((ext_vector_type(2)));
typedef float f32x4 __attribute__((ext_vector_type(4)));
typedef float f32x2 __attribute__((ext_vector_type(2)));
typedef float f32x16 __attribute__((ext_vector_type(16)));
typedef short bf16x8 __attribute__((ext_vector_type(8)));
typedef short s16x4 __attribute__((ext_vector_type(4)));
typedef __bf16 bf16x2_t __attribute__((ext_vector_type(2)));
#define LDS_WAIT() asm volatile("s_waitcnt lgkmcnt(0)" ::: "memory")
#define VM_WAIT() asm volatile("s_waitcnt vmcnt(0)" ::: "memory")
DI unsigned pk2(float lo, float hi) { f32x2 v = {lo, hi}; bf16x2_t b = __builtin_convertvector(v, bf16x2_t); return __builtin_bit_cast(unsigned, b); }
DI float bf_lo(unsigned w) { return __uint_as_float(w << 16); }
DI float bf_hi(unsigned w) { return __uint_as_float(w & 0xffff0000u); }
DI float bf2f(bf16 b) { return __uint_as_float(((unsigned)b) << 16); }

#define XB_TMO      128
#define XB_XCNT(j)  (256  + 64 * (j))
#define XB_XSUB(j)  (1280 + 64 * (j))
#define XB_XGEN(j)  (2304 + 64 * (j))
#define XB_TOP      3328
#define XB_TOPGEN   3392
#define XCD_BAR_WORDS 3456
#define XB_SPIN_CAP (1u << 21)
DI unsigned xb_ld(unsigned* p)              { return __hip_atomic_load(p, __ATOMIC_RELAXED, __HIP_MEMORY_SCOPE_AGENT); }
DI unsigned xb_add(unsigned* p, unsigned v) { return __hip_atomic_fetch_add(p, v, __ATOMIC_RELAXED, __HIP_MEMORY_SCOPE_AGENT); }
DI unsigned xb_xcc_id() { return (unsigned)__builtin_amdgcn_s_getreg((3 << 11) | 20) & 0xFu; }
#define XB_SPIN(cond, bar) do { unsigned _sp = 0; while (cond) { __builtin_amdgcn_s_sleep(1); \
    if ((++_sp & 255u) == 0u) { if (xb_ld(&(bar)[XB_TMO])) break; if (_sp > XB_SPIN_CAP) { atomicAdd(&(bar)[XB_TMO], 1u); break; } } } } while (0)
DI unsigned long long ptab_get(LAS const unsigned long long* PT, int i) { const unsigned long long v = PT[i];
    const unsigned lo = __builtin_amdgcn_readfirstlane((unsigned)v), hi = __builtin_amdgcn_readfirstlane((unsigned)(v >> 32)); return ((unsigned long long)hi << 32) | lo; }
struct XcdBarrier { LAS const unsigned long long* pt; unsigned x; volatile LAS unsigned* st; };
DI unsigned* xb_words(LAS const unsigned long long* pt) { return (unsigned*)(GAS unsigned*)(ptab_get(pt, 26) + WS_CTL) + CW_BAR; }
DI XcdBarrier xcd_barrier_post(LAS const unsigned long long* pt, volatile LAS unsigned* st) {
    XcdBarrier b; b.pt = pt; b.x = xb_xcc_id(); b.st = st; unsigned* bar = xb_words(pt);
    if (threadIdx.x == 0) (void)xb_add(&bar[XB_XCNT(b.x)], 1u);
    return b;
}
DI void xcd_barrier_complete(unsigned* bar, unsigned x, unsigned& nloc, unsigned& nx) {
    const unsigned G = gridDim.x * gridDim.y * gridDim.z;
    unsigned sum, cnt, mine, sp = 0u;
    for (;;) {
        sum = 0u; cnt = 0u; mine = 0u;
#pragma unroll
        for (unsigned j = 0; j < 16; ++j) { const unsigned c = xb_ld(&bar[XB_XCNT(j)]); sum += c; cnt += (c > 0u) ? 1u : 0u; mine = (j == x) ? c : mine; }
        if (sum == G) break;
        __builtin_amdgcn_s_sleep(1);
        if ((++sp & 255u) == 0u) { if (xb_ld(&bar[XB_TMO])) break; if (sp > XB_SPIN_CAP) { atomicAdd(&bar[XB_TMO], 1u); break; } }
    }
    nloc = mine > 0u ? mine : 1u; nx = cnt > 0u ? cnt : 1u;
}
DI void xcd_barrier(const XcdBarrier& b) {
    asm volatile("s_waitcnt vmcnt(0)" ::: "memory");
    __syncthreads();
    if (threadIdx.x == 0) {
        unsigned* bar = xb_words(b.pt); const unsigned bx_ = xb_xcc_id();
        __builtin_amdgcn_s_waitcnt(0);
        unsigned nloc = b.st[0], nx = b.st[1];
        if (nloc == 0u) { xcd_barrier_complete(bar, bx_, nloc, nx); b.st[0] = nloc; b.st[1] = nx; }
        const unsigned old = xb_add(&bar[XB_XSUB(bx_)], 1u);
        const unsigned gen = old / nloc;
        if (old + 1u == (gen + 1u) * nloc) {
            __builtin_amdgcn_fence(__ATOMIC_RELEASE, "agent");
            asm volatile("s_waitcnt vmcnt(0)" ::: "memory");
            const unsigned og = xb_add(&bar[XB_TOP], 1u);
            const unsigned tg = og / nx;
            if (og + 1u == (tg + 1u) * nx) xb_add(&bar[XB_TOPGEN], 1u);
            else XB_SPIN(xb_ld(&bar[XB_TOPGEN]) == tg, bar);
            __builtin_amdgcn_fence(__ATOMIC_ACQUIRE, "agent");
            xb_add(&bar[XB_XGEN(bx_)], 1u);
            asm volatile("s_waitcnt vmcnt(0)" ::: "memory");
        } else {
            XB_SPIN(xb_ld(&bar[XB_XGEN(bx_)]) == gen, bar);
            __builtin_amdgcn_fence(__ATOMIC_ACQUIRE, "agent");
            asm volatile("s_waitcnt vmcnt(0)" ::: "memory");
        }
    }
    __syncthreads();
}
DI float shx(float v, int mask, int lane) { return __builtin_bit_cast(float, __builtin_amdgcn_ds_bpermute((lane ^ mask) << 2, __builtin_bit_cast(int, v))); }
DI float shi(float v, int src) { return __builtin_bit_cast(float, __builtin_amdgcn_ds_bpermute(src << 2, __builtin_bit_cast(int, v))); }
DI float wave_sum(float v, int lane) {
#pragma unroll
    for (int o = 1; o < 64; o <<= 1) v += shx(v, o, lane);
    return v;
}

struct Ctx { int tid, lane, wave, vcu, G, gw, NGW; };

template <int MAP> DI int map_src_col(int n0) {
    if (MAP == 1) { const int hc = n0 / QCW, rem = n0 % QCW, gt = rem / (HC * HD), rem2 = rem % (HC * HD), hl = rem2 / HD, d0 = rem2 % HD; return (gt * 16 + hc * HC + hl) * HD + d0; }
    if (MAP == 2) { const int ch = n0 / UCW, rem = n0 % UCW, p = rem / CCH, cl = rem % CCH; return p * D + ch * CCH + cl; }
    return n0;
}
DI void transpose_item(const float* W, int K, int Nsrc, bf16* WT, int n0dst, int n0src, int k0, LAS float* scr, int lane, const float* gain, bool perm, int hb) {
    const int r = lane >> 4, q = lane & 15;
    const int srcc = perm ? n0src + 32 * hb + (q < 8 ? 4 * q : 64 + 4 * (q - 8)) : n0src + 4 * q;
    f32x4 v[16];
#pragma unroll
    for (int i = 0; i < 16; ++i) v[i] = __builtin_nontemporal_load((const GAS f32x4*)(W + (size_t)(k0 + 4 * i + r) * Nsrc + srcc));
    if (gain) {
#pragma unroll
        for (int i = 0; i < 16; ++i) v[i] = v[i] * gain[k0 + 4 * i + r]; }
#pragma unroll
    for (int i = 0; i < 16; ++i) { LAS float* d = scr + (4 * i + r) * 65 + 4 * q; d[0] = v[i].x; d[1] = v[i].y; d[2] = v[i].z; d[3] = v[i].w; }
    LDS_WAIT(); asm volatile("" ::: "memory");
    const int c = lane & 7;
#pragma unroll
    for (int j = 0; j < 8; ++j) { const int n = (lane >> 3) + 8 * j; const LAS float* s = scr + (8 * c) * 65 + n;
        const int prow = perm ? 32 * ((n >> 4) & 1) + 8 * ((n >> 2) & 3) + 4 * (n >> 5) + (n & 3) : n;
        v4u o; o.x = pk2(s[0 * 65], s[1 * 65]); o.y = pk2(s[2 * 65], s[3 * 65]); o.z = pk2(s[4 * 65], s[5 * 65]); o.w = pk2(s[6 * 65], s[7 * 65]);
        *(GAS v4u*)(WT + (size_t)(n0dst + prow) * K + k0 + 8 * c) = o; }
    LDS_WAIT(); asm volatile("" ::: "memory");
}
template <int MAP> DI void convert_matrix(const Ctx& C, LAS float* scr, const float* W, int K, int Nsrc, int Ndst, bf16* WT, int& item_base, const float* gain) {
    const int nblk = Ndst / 64, nitems = (K / 64) * nblk;
    int first = C.gw - (item_base % C.NGW); if (first < 0) first += C.NGW;
    for (int it = first; it < nitems; it += C.NGW) { const int kb = it / nblk, nb = it % nblk;
        bool perm = false; int hb = 0, srcb = map_src_col<MAP>(nb * 64);
        if (MAP == 1) { const int rem = (nb * 64) % QCW, gt = rem / (HC * HD); perm = (gt % 3) != 2; hb = (nb * 64 % HD) / 64; if (perm) srcb -= 64 * hb; }
        transpose_item(W, K, Nsrc, WT, nb * 64, srcb, kb * 64, scr, C.lane, gain, perm, hb); }
    item_base += nitems;
}

DI void ph_x0(const Ctx& C, const float* xp, const float* xs, bf16* XB, float* SS) {
    for (int m = C.gw; m < M; m += C.NGW) {
        const float* src = (m < MP) ? xp + (size_t)m * D : xs + (size_t)(m - MP) * D;
        const GAS f32x4* xr = (const GAS f32x4*)src + C.lane;
        f32x4 v[8]; float s = 0.f;
#pragma unroll
        for (int j = 0; j < 8; ++j) { v[j] = xr[64 * j]; s += (v[j].x * v[j].x + v[j].y * v[j].y) + (v[j].z * v[j].z + v[j].w * v[j].w); }
        s = wave_sum(s, C.lane);
        GAS v2u* o8 = (GAS v2u*)(XB + (size_t)m * D) + C.lane;
#pragma unroll
        for (int j = 0; j < 8; ++j) { v2u o; o.x = pk2(v[j].x, v[j].y); o.y = pk2(v[j].z, v[j].w); o8[64 * j] = o; }
        if (C.lane < 8) SS[(size_t)m * 8 + C.lane] = C.lane == 0 ? s : 0.f;
    }
}
DI int row_pos(int m) { return (m < MP) ? (m & (LP - 1)) : ((m - MP) & (LS - 1)); }

constexpr float QSCALE = 0.08838834764831845f * 1.4426950408889634f;
DI void ph_qkprep(const Ctx& C, bf16* QKVC, const float* qgain  , const float* kgain  ) {
    const int sub = C.lane & 15, d0 = 4 * sub;
    float inv[4];
#pragma unroll
    for (int e = 0; e < 4; ++e) inv[e] = exp2f(-(float)(d0 + e) * (13.287712379549449f / 64.0f));
    constexpr int NIT = (6 * HC) / 4;
    for (int m = C.gw; m < M; m += C.NGW) {
        bf16* rowp = QKVC + (size_t)m * QCW;
        v2u ra[NIT], rb[NIT];
#pragma unroll
        for (int it = 0; it < NIT; ++it) { const int vv = it * 4 + (C.lane >> 4), gtt = vv / HC, hl = vv % HC, g = gtt >> 1, t = gtt & 1;
            const bf16* p = rowp + ((g * 3 + t) * HC + hl) * HD + d0; ra[it] = *(const GAS v2u*)p; rb[it] = *(const GAS v2u*)(p + 64); }
        const float pos = (float)row_pos(m);
        float cs[4], sn[4];
#pragma unroll
        for (int e = 0; e < 4; ++e) { const float ang = pos * inv[e]; float rev = ang * 0.15915494309189535f; rev -= floorf(rev); cs[e] = __builtin_amdgcn_cosf(rev); sn[e] = __builtin_amdgcn_sinf(rev); }
#pragma unroll
        for (int it = 0; it < NIT; ++it) {
            const int vv = it * 4 + (C.lane >> 4), gtt = vv / HC, hl = vv % HC, g = gtt >> 1, t = gtt & 1;
            bf16* p = rowp + ((g * 3 + t) * HC + hl) * HD + d0;
            const v2u a = ra[it], b = rb[it];
            float x1[4] = {bf_lo(a.x), bf_hi(a.x), bf_lo(a.y), bf_hi(a.y)}, x2[4] = {bf_lo(b.x), bf_hi(b.x), bf_lo(b.y), bf_hi(b.y)};
            float ss = 0.f;
#pragma unroll
            for (int e = 0; e < 4; ++e) ss += x1[e] * x1[e] + x2[e] * x2[e];
            ss += shx(ss, 1, C.lane); ss += shx(ss, 2, C.lane); ss += shx(ss, 4, C.lane); ss += shx(ss, 8, C.lane);
            float r = 1.0f / sqrtf(ss * (1.f / HD) + RMS_EPS);
            const float* gp = (t == 0 ? qgain : kgain) + g * HD + d0;
            const f32x4 g1 = *(const GAS f32x4*)gp, g2 = *(const GAS f32x4*)(gp + 64);
            if (t == 0) r *= QSCALE;
            float o1[4], o2[4];
#pragma unroll
            for (int e = 0; e < 4; ++e) { const float y1 = x1[e] * r * g1[e], y2 = x2[e] * r * g2[e]; o1[e] = y1 * cs[e] - y2 * sn[e]; o2[e] = y2 * cs[e] + y1 * sn[e]; }
            v2u oa, ob; oa.x = pk2(o1[0], o1[1]); oa.y = pk2(o1[2], o1[3]); ob.x = pk2(o2[0], o2[1]); ob.y = pk2(o2[2], o2[3]);
            *(GAS v2u*)p = oa; *(GAS v2u*)(p + 64) = ob;
        }
    }
}

#ifndef MK_OG_INPLACE
#define MK_OG_INPLACE 1
#endif
DI bf16* og_ptr(bf16* OG, int g, int tok, int hl) { return MK_OG_INPLACE ? OG + (size_t)tok * QCW + ((g * 3) * HC + hl) * HD : OG + ((size_t)g * M + tok) * (HC * HD) + hl * HD; }
DI int crow(int r, int hi) { return (r & 3) + 8 * (r >> 2) + 4 * hi; }
constexpr int VPITCH = 320, KPITCH = 272, KIMG_BYTES = 32 * KPITCH, ATT_WAVE_BYTES = KIMG_BYTES + 32 * VPITCH;
#define TR4(a, b, c, d, addr, o0, o1, o2, o3) asm volatile("ds_read_b64_tr_b16 %0, %4 offset:%c5\n\tds_read_b64_tr_b16 %1, %4 offset:%c6\n\tds_read_b64_tr_b16 %2, %4 offset:%c7\n\tds_read_b64_tr_b16 %3, %4 offset:%c8\n\ts_waitcnt lgkmcnt(0)" \
    : "=&v"(a), "=&v"(b), "=&v"(c), "=&v"(d) : "v"(addr), "i"(o0), "i"(o1), "i"(o2), "i"(o3) : "memory")
constexpr int ATT_SEG = 16, ATT_NT = M / 32, ATT_NSEG = ATT_NT / ATT_SEG;
constexpr int ATT_KS = 0, ATT_VS = 4 * KIMG_BYTES, ATT_QW = ATT_VS + 4 * 32 * VPITCH;
static_assert(ATT_QW + 8 * KIMG_BYTES <= SCRATCH_BYTES, "attention LDS map");
DI void attn_decode(int tt, int dsh, int& base_row, int& j, int& run_lo, int& run_hi) {
    int row0, w, sh, t0;
    if (tt < 256) { row0 = (tt >> 6) * LP; w = tt & 63; sh = 6 - dsh; } else { const int q = tt - 256; row0 = MP + (q >> 9) * LS; w = q & 511; sh = 9 - dsh; }
    t0 = tt - w; const int r = w >> sh; j = w & ((1 << sh) - 1); base_row = row0 + r; run_lo = t0 + (r << sh); run_hi = run_lo + (1 << sh);
}
DI void attn_segment(const bf16* QKVC, bf16* OG, float* LSE, int g, int hl, int seg, int t0, int nt, int wave, int tid, LAS unsigned char* lds, unsigned lds_addr) {
    const int lane = tid & 63;
    LAS unsigned char* kl = lds + ATT_QW + wave * KIMG_BYTES;
    const int dsh = 2 * g, dil = 1 << dsh;
    const int ql = lane & 31, hi = lane >> 5, lr = lane >> 4, lc = lane & 15, prow = tid >> 4, pch = tid & 15;
    const int qcol = ((g * 3 + 0) * HC + hl) * HD, kcol = ((g * 3 + 1) * HC + hl) * HD, vcol = ((g * 3 + 2) * HC + hl) * HD;
    const unsigned tr_off = (unsigned)((4 * hi + ((lane & 15) >> 2)) * VPITCH + ((lane >> 4) & 1) * 32 + (lane & 3) * 8);
    const int seg0 = seg * ATT_SEG + t0, c0 = seg0 - 2, clast = seg0 + nt + 1, nkq = nt >> 3;
    bf16x8 qf[8]; f32x16 o[4]; float mrun = -INFINITY, lrun = 0.f;
    int base_row = 0, jq = 0, run_lo = 0, run_hi = 0; bool started = false;
#pragma unroll
    for (int c = 0; c < 4; ++c)
#pragma unroll
        for (int i = 0; i < 16; ++i) o[c][i] = 0.f;
#pragma unroll
    for (int s = 0; s < 8; ++s) qf[s] = (bf16x8){0, 0, 0, 0, 0, 0, 0, 0};
#define ATT_LOADT(c_, kr_, vr_) do { kr_ = (v4u){0u, 0u, 0u, 0u}; vr_ = kr_; if ((c_) >= 0 && (c_) < ATT_NT) { int br_, j_, lo_, hi_; attn_decode((c_), dsh, br_, j_, lo_, hi_); \
        const bf16* rp_ = QKVC + (size_t)(br_ + dil * (32 * j_ + prow)) * QCW + 8 * pch; kr_ = __builtin_nontemporal_load((const GAS v4u*)(rp_ + kcol)); vr_ = __builtin_nontemporal_load((const GAS v4u*)(rp_ + vcol)); } } while (0)
    v4u kr0, vr0, kr1, vr1;
    ATT_LOADT(c0, kr0, vr0); ATT_LOADT(c0 + 1, kr1, vr1);
#define ATT_PAIR(c_, b_) do { \
        *(LAS v4u*)(lds + ATT_KS + (b_) * KIMG_BYTES + prow * KPITCH + pch * 16) = kr0; *(LAS v4u*)(lds + ATT_VS + (b_) * (32 * VPITCH) + prow * VPITCH + pch * 16) = vr0; \
        *(LAS v4u*)(lds + ATT_KS + ((b_) + 1) * KIMG_BYTES + prow * KPITCH + pch * 16) = kr1; *(LAS v4u*)(lds + ATT_VS + ((b_) + 1) * (32 * VPITCH) + prow * VPITCH + pch * 16) = vr1; \
        if ((c_) + 2 <= clast) { ATT_LOADT((c_) + 2, kr0, vr0); ATT_LOADT((c_) + 3, kr1, vr1); } \
        LDS_WAIT(); __builtin_amdgcn_s_barrier(); asm volatile("" ::: "memory"); \
        attn_tile((c_), (b_)); attn_tile((c_) + 1, (b_) + 1); } while (0)
    auto attn_tile = [&](int c, int b) __attribute__((always_inline)) {
        const int d = c - seg0 - wave + 2, kq = d >> 3, rem = d & 7;
        if (d < 0 || rem > 4 || kq >= nkq) return;
        const int cq = seg0 + wave + 8 * kq;
        if (!started) attn_decode(cq, dsh, base_row, jq, run_lo, run_hi);
        if (c < run_lo || c >= run_hi) return;
        if (!started) {
            started = true;
            v4u qraw[8];
#pragma unroll
            for (int it = 0; it < 8; ++it) qraw[it] = __builtin_nontemporal_load((const GAS v4u*)(QKVC + (size_t)(base_row + dil * (32 * jq + lr + 4 * it)) * QCW + qcol + 8 * lc));
#pragma unroll
            for (int it = 0; it < 8; ++it) *(LAS v4u*)(kl + (lr + 4 * it) * KPITCH + lc * 16) = qraw[it];
            LDS_WAIT();
#pragma unroll
            for (int s = 0; s < 8; ++s) qf[s] = *(const LAS bf16x8*)(kl + ql * KPITCH + 32 * s + 16 * hi);
            LDS_WAIT(); asm volatile("" ::: "memory");
#pragma unroll
            for (int cc = 0; cc < 4; ++cc)
#pragma unroll
                for (int i = 0; i < 16; ++i) o[cc][i] = 0.f;
            mrun = -INFINITY; lrun = 0.f;
        }
        const bool last_tile = (c == cq + 2) || (c == run_hi - 1);
        const LAS unsigned char* ks = lds + ATT_KS + b * KIMG_BYTES;
        bf16x8 kf[8];
#pragma unroll
        for (int s8 = 0; s8 < 8; ++s8) kf[s8] = *(const LAS bf16x8*)(ks + ql * KPITCH + 32 * s8 + 16 * hi);
        f32x16 s;
#pragma unroll
        for (int i = 0; i < 16; ++i) s[i] = 0.f;
        __builtin_amdgcn_s_setprio(1);
#pragma unroll
        for (int k8 = 0; k8 < 8; ++k8) s = __builtin_amdgcn_mfma_f32_32x32x16_bf16(kf[k8], qf[k8], s, 0, 0, 0);
        __builtin_amdgcn_s_setprio(0);
        if (c == cq - 2) {
#pragma unroll
            for (int i = 0; i < 16; ++i) if (crow(i, hi) < ql) s[i] = -INFINITY;
        } else if (c == cq + 2) {
#pragma unroll
            for (int i = 0; i < 16; ++i) if (crow(i, hi) > ql) s[i] = -INFINITY;
        }
        float mx = s[0];
#pragma unroll
        for (int i = 1; i < 16; ++i) mx = fmaxf(mx, s[i]);
        mx = fmaxf(mx, shx(mx, 32, lane));
        const float mnew = fmaxf(mrun, mx);
        if (__builtin_amdgcn_ballot_w64(mnew - mrun > 8.0f) != 0ull) {
            const float alpha = __builtin_amdgcn_exp2f(mrun - mnew);
            lrun *= alpha; mrun = mnew;
#pragma unroll
            for (int cc = 0; cc < 4; ++cc)
#pragma unroll
                for (int i = 0; i < 16; ++i) o[cc][i] *= alpha;
        }
        float ls = 0.f;
#pragma unroll
        for (int i = 0; i < 16; ++i) { s[i] = __builtin_amdgcn_exp2f(s[i] - mrun); ls += s[i]; }
        lrun += ls;
        bf16x8 pf[2];
#pragma unroll
        for (int sp = 0; sp < 2; ++sp) { v4u pw; pw.x = pk2(s[8 * sp + 0], s[8 * sp + 1]); pw.y = pk2(s[8 * sp + 2], s[8 * sp + 3]); pw.z = pk2(s[8 * sp + 4], s[8 * sp + 5]); pw.w = pk2(s[8 * sp + 6], s[8 * sp + 7]); pf[sp] = __builtin_bit_cast(bf16x8, pw); }
        const unsigned tr_base = lds_addr + (unsigned)(ATT_VS + b * (32 * VPITCH)) + tr_off;
        s16x4 ta[4][4];
#pragma unroll
        for (int cc = 0; cc < 4; ++cc)
            asm volatile("ds_read_b64_tr_b16 %0, %4 offset:%c5\n\tds_read_b64_tr_b16 %1, %4 offset:%c6\n\tds_read_b64_tr_b16 %2, %4 offset:%c7\n\tds_read_b64_tr_b16 %3, %4 offset:%c8"
                : "=&v"(ta[cc][0]), "=&v"(ta[cc][1]), "=&v"(ta[cc][2]), "=&v"(ta[cc][3]) : "v"(tr_base), "i"(64 * cc), "i"(8 * VPITCH + 64 * cc), "i"(16 * VPITCH + 64 * cc), "i"(24 * VPITCH + 64 * cc) : "memory");
        asm volatile("s_waitcnt lgkmcnt(0)" : "+v"(ta[0][0]), "+v"(ta[0][1]), "+v"(ta[0][2]), "+v"(ta[0][3]), "+v"(ta[1][0]), "+v"(ta[1][1]), "+v"(ta[1][2]), "+v"(ta[1][3]),
                                              "+v"(ta[2][0]), "+v"(ta[2][1]), "+v"(ta[2][2]), "+v"(ta[2][3]), "+v"(ta[3][0]), "+v"(ta[3][1]), "+v"(ta[3][2]), "+v"(ta[3][3]) :: "memory");
        __builtin_amdgcn_s_setprio(1);
#pragma unroll
        for (int cc = 0; cc < 4; ++cc) {
            const bf16x8 v0 = __builtin_shufflevector(ta[cc][0], ta[cc][1], 0, 1, 2, 3, 4, 5, 6, 7), v1 = __builtin_shufflevector(ta[cc][2], ta[cc][3], 0, 1, 2, 3, 4, 5, 6, 7);
            o[cc] = __builtin_amdgcn_mfma_f32_32x32x16_bf16(v0, pf[0], o[cc], 0, 0, 0);
            o[cc] = __builtin_amdgcn_mfma_f32_32x32x16_bf16(v1, pf[1], o[cc], 0, 0, 0);
        }
        __builtin_amdgcn_s_setprio(0);
        if (last_tile) {
            started = false;
            const float ltot = lrun + shx(lrun, 32, lane);
            const float rinv = 1.0f / ltot;
#pragma unroll
            for (int cc = 0; cc < 4; ++cc)
#pragma unroll
                for (int g4 = 0; g4 < 4; ++g4) { v2u w2; w2.x = pk2(o[cc][4 * g4] * rinv, o[cc][4 * g4 + 1] * rinv); w2.y = pk2(o[cc][4 * g4 + 2] * rinv, o[cc][4 * g4 + 3] * rinv);
                    *(LAS v2u*)(kl + ql * KPITCH + (32 * cc + 8 * g4 + 4 * hi) * 2) = w2; }
            LDS_WAIT(); asm volatile("" ::: "memory");
#pragma unroll
            for (int it = 0; it < 8; ++it) { const v4u ov = *(const LAS v4u*)(kl + (lr + 4 * it) * KPITCH + lc * 16);
                *(GAS v4u*)(og_ptr(OG, g, base_row + dil * (32 * jq + lr + 4 * it), hl) + 8 * lc) = ov; }
            LDS_WAIT(); asm volatile("" ::: "memory");
            if (hi == 0) LSE[((size_t)g * M + (size_t)(base_row + dil * (32 * jq + ql))) * HC + hl] = mrun + __builtin_amdgcn_logf(ltot);
        }
    };
    static_assert((ATT_SEG + 4) % 4 == 0, "pairs of pairs");
    for (int c = c0; c <= clast; c += 4) { ATT_PAIR(c, 0); ATT_PAIR(c + 2, 2); }
#undef ATT_LOADT
#undef ATT_PAIR
}
DI void ph_attn(const Ctx& C, const bf16* QKVC, bf16* OG, float* LSE, unsigned char* lds_generic) {
    const unsigned lds_addr = (unsigned)(size_t)(lds_generic);
    constexpr int NSU = 3 * HC * ATT_NSEG;
    const int nfull = (NSU / C.G) * C.G, rem_su = NSU - nfull; const bool halves = 2 * rem_su <= C.G;
    for (int su = C.vcu; su < (halves ? nfull : NSU); su += C.G) { const int g = su / (HC * ATT_NSEG), rem = su % (HC * ATT_NSEG);
        __syncthreads();
        attn_segment(QKVC, OG, LSE, g, rem / ATT_NSEG, rem % ATT_NSEG, 0, ATT_SEG, C.wave, C.tid, (LAS unsigned char*)lds_generic, lds_addr); }
    if (halves && C.vcu < 2 * rem_su) { const int su = nfull + (C.vcu >> 1), g = su / (HC * ATT_NSEG), rem = su % (HC * ATT_NSEG);
        __syncthreads();
        attn_segment(QKVC, OG, LSE, g, rem / ATT_NSEG, rem % ATT_NSEG, 8 * (C.vcu & 1), 8, C.wave, C.tid, (LAS unsigned char*)lds_generic, lds_addr); }
    __syncthreads();
}
#ifndef CMB_RB
#define CMB_RB 4
#endif
DI void ph_combine(const Ctx& C, const bf16* OG, const float* LSE, bf16* AO, int hc) {
    const int d0 = (C.lane & 15) * 8;
    constexpr int RB = CMB_RB, NS = RB * (HC / 4);
    for (int m0 = C.gw; m0 < M; m0 += RB * C.NGW) {
        float ls[NS][3]; v4u og[NS][3];
#pragma unroll
        for (int q = 0; q < NS; ++q) { const int mm = m0 + (q / (HC / 4)) * C.NGW, m = mm < M ? mm : m0, hl = (q % (HC / 4)) * 4 + (C.lane >> 4);
#pragma unroll
            for (int g = 0; g < 3; ++g) { ls[q][g] = LSE[((size_t)g * M + m) * HC + hl]; og[q][g] = *(const GAS v4u*)(og_ptr((bf16*)OG, g, m, hl) + d0); } }
#pragma unroll
        for (int q = 0; q < NS; ++q) { const int m = m0 + (q / (HC / 4)) * C.NGW, hl = (q % (HC / 4)) * 4 + (C.lane >> 4);
            const float mx = fmaxf(ls[q][0], fmaxf(ls[q][1], ls[q][2]));
            float w[3]; float ws = 0.f;
#pragma unroll
            for (int g = 0; g < 3; ++g) { w[g] = __builtin_amdgcn_exp2f(ls[q][g] - mx); ws += w[g]; }
            const float rw = 1.0f / ws;
            float acc[8] = {0.f, 0.f, 0.f, 0.f, 0.f, 0.f, 0.f, 0.f};
#pragma unroll
            for (int g = 0; g < 3; ++g) { const float wg = w[g] * rw; const unsigned qq[4] = {og[q][g].x, og[q][g].y, og[q][g].z, og[q][g].w};
#pragma unroll
                for (int e = 0; e < 4; ++e) { acc[2 * e] += wg * bf_lo(qq[e]); acc[2 * e + 1] += wg * bf_hi(qq[e]); } }
            v4u o; o.x = pk2(acc[0], acc[1]); o.y = pk2(acc[2], acc[3]); o.z = pk2(acc[4], acc[5]); o.w = pk2(acc[6], acc[7]);
            if (m < M) *(GAS v4u*)(AO + (size_t)m * D + (hc * HC + hl) * HD + d0) = o;
        }
    }
}

DI void ph_filter_hidden(const Ctx& C, const float* w1, const float* b1, const float* w2, const float* b2, const float* w3, const float* b3, const float* fr, float* H3f) {
    bf16* const H3 = (bf16*)H3f;
    const int lane = C.lane;
    const float frq = fr[lane], bb1 = b1[lane], bb2 = b2[lane], bb3 = b3[lane];
    for (int pi = C.gw; pi < NPOS; pi += C.NGW) {
        const int Lk = pi < LP ? LP : LS; const float pos = (float)(pi < LP ? pi : pi - LP);
        const float t = pos / (float)(Lk - 1);
        float z = 0.f;
        if (lane == 0) z = t;
        else if (lane <= 32) { const int k = (lane - 1) & 15; const float band = 1e-4f + (float)k * ((15.0f - 1e-4f) / 15.0f); const float ang = ((float)(6.283185307179586 / (double)Lk) * pos) * band; z = lane <= 16 ? cosf(ang) : -sinf(ang); }
        float a = bb1;
#pragma unroll
        for (int i = 0; i < 33; ++i) a += __builtin_bit_cast(float, __builtin_amdgcn_readlane(__builtin_bit_cast(int, z), i)) * w1[i * 64 + lane];
        float h = sinf(frq * a);
        a = bb2;
#pragma unroll 16
        for (int i = 0; i < 64; ++i) a += __builtin_bit_cast(float, __builtin_amdgcn_readlane(__builtin_bit_cast(int, h), i)) * w2[i * 64 + lane];
        h = sinf(frq * a);
        a = bb3;
#pragma unroll 16
        for (int i = 0; i < 64; ++i) a += __builtin_bit_cast(float, __builtin_amdgcn_readlane(__builtin_bit_cast(int, h), i)) * w3[i * 64 + lane];
        h = sinf(frq * a);
        { const unsigned hw = pk2(h, 0.f); H3[(size_t)pi * 64 + lane] = __builtin_bit_cast(bf16, (unsigned short)(hw & 0xffffu)); }
    }
}
DI void ph_filter_gen(const Ctx& C, unsigned char* lds_generic, const float* H3f, const float* w4  , unsigned* HT, int ch) {
    const bf16* const H3 = (const bf16*)H3f;
    LAS unsigned short* wl = (LAS unsigned short*)lds_generic;
    constexpr int NCOL = 2 * CCH, WP = 72, CB = 512, NPT = NPOS / 32, NCT = CB / 32;
    const int ql = C.lane & 31, hi = C.lane >> 5;
    constexpr int NCB = NCOL / CB;
    const bool split = (C.G % NCB) == 0;
    const int cb_lo = split ? C.vcu % NCB : 0, cb_hi = split ? cb_lo + 1 : NCB;
    const int gwl = split ? (C.vcu / NCB) * NWAVES + C.wave : C.gw, ngwl = split ? (C.G / NCB) * NWAVES : C.NGW;
    for (int cb = cb_lo; cb < cb_hi; ++cb) {
        __syncthreads();
        { const int q = cb * CB + C.tid, dir = q / CCH, cl = q % CCH; const float* wp = w4 + dir * D + ch * CCH + cl;
#pragma unroll 1
          for (int ib = 0; ib < 4; ++ib) { float wv[16];
#pragma unroll
              for (int t = 0; t < 16; ++t) wv[t] = wp[(size_t)(ib * 16 + t) * (2 * D)];
              v4u p0, p1; p0.x = pk2(wv[0], wv[1]); p0.y = pk2(wv[2], wv[3]); p0.z = pk2(wv[4], wv[5]); p0.w = pk2(wv[6], wv[7]); p1.x = pk2(wv[8], wv[9]); p1.y = pk2(wv[10], wv[11]); p1.z = pk2(wv[12], wv[13]); p1.w = pk2(wv[14], wv[15]);
              *(LAS v4u*)(wl + C.tid * WP + ib * 16) = p0; *(LAS v4u*)(wl + C.tid * WP + ib * 16 + 8) = p1; } }
        __syncthreads();
        v4u hb[4];
        if (gwl < NPT * NCT) { const int pi = (gwl / NCT) * 32 + ql;
#pragma unroll
            for (int s = 0; s < 4; ++s) hb[s] = *(const GAS v4u*)(H3 + (size_t)pi * 64 + 16 * s + 8 * hi); }
        for (int wt = gwl; wt < NPT * NCT; wt += ngwl) {
            const int pt = wt / NCT, ct = wt % NCT, pi = pt * 32 + ql;
            const int Lk = pi < LP ? LP : LS; const float pos = (float)(pi < LP ? pi : pi - LP), t = pos / (float)(Lk - 1), sc = 1.0f / (float)(2 * Lk);
            v4u hc[4];
#pragma unroll
            for (int s = 0; s < 4; ++s) hc[s] = hb[s];
            if (wt + ngwl < NPT * NCT) { const int pi2 = ((wt + ngwl) / NCT) * 32 + ql;
#pragma unroll
                for (int s = 0; s < 4; ++s) hb[s] = *(const GAS v4u*)(H3 + (size_t)pi2 * 64 + 16 * s + 8 * hi); }
            f32x16 acc;
#pragma unroll
            for (int i = 0; i < 16; ++i) acc[i] = 0.f;
#pragma unroll
            for (int s = 0; s < 4; ++s) {
                const bf16x8 a = *(const LAS bf16x8*)(wl + (ct * 32 + ql) * WP + 16 * s + 8 * hi);
                acc = __builtin_amdgcn_mfma_f32_32x32x16_bf16(a, __builtin_bit_cast(bf16x8, hc[s]), acc, 0, 0, 0);
            }
#pragma unroll
            for (int i = 0; i < 16; i += 2) { const int q = cb * CB + ct * 32 + crow(i, hi), dir = q / CCH, cl = q % CCH, c = ch * CCH + cl;
                const float d0 = fabsf(-3.0701134573253945f + (float)c * ((-15.350567286626972f + 3.0701134573253945f) / 2047.0f)), d1 = fabsf(-3.0701134573253945f + (float)(c + 1) * ((-15.350567286626972f + 3.0701134573253945f) / 2047.0f));
                HT[((size_t)cl + dir) * NPOS + pi] = pk2(acc[i] * __expf(-t * d0) * sc, acc[i + 1] * __expf(-t * d1) * sc); }
        }
    }
    __syncthreads();
}
DI void pair_geom(int ps, int& rowA, int& rowB, int& Lq, int& pp0) { if (ps == 0) { rowA = 0; rowB = LP; Lq = LP; pp0 = 0; } else if (ps == 1) { rowA = 2 * LP; rowB = 3 * LP; Lq = LP; pp0 = LP; } else { rowA = MP; rowB = MP + LS; Lq = LS; pp0 = 2 * LP; } }
struct GateGeom { int ct, ppt, rowA, rowB, Lq, t; bool valid; };
DI GateGeom gate_geom(const Ctx& C, int i, bool fastmap, int tl) {
    constexpr int NTT = PPOS / 64, NCT = CCH / 64;
    GateGeom g; int ptile;
    if (fastmap) { g.ct = C.vcu % NCT; ptile = C.vcu / NCT + (C.G / NCT) * i; } else { const int un = C.vcu + C.G * i; g.ct = un % NCT; ptile = un / NCT; }
    g.valid = ptile < NTT; if (!g.valid) ptile = 0;
    g.ppt = ptile * 64;
    const int ps = g.ppt < LP ? 0 : (g.ppt < 2 * LP ? 1 : 2);
    int pp0; pair_geom(ps, g.rowA, g.rowB, g.Lq, pp0);
    g.t = g.ppt - pp0 + tl;
    return g;
}
#define GATE_LOAD(gg) do { const int tm_ = (gg).t > 0 ? (gg).t - 1 : 0, tp_ = (gg).t < (gg).Lq - 1 ? (gg).t + 1 : (gg).Lq - 1; \
    _Pragma("unroll") for (int bb = 0; bb < 2; ++bb) { const bf16* ub = U + (size_t)(bb ? (gg).rowB : (gg).rowA) * UCW + (gg).ct * 64 + c8 * 8; \
    _Pragma("unroll") for (int p = 1; p < 3; ++p) { raw[bb][p - 1][0] = *(const GAS v4u*)(ub + (size_t)tm_ * UCW + p * CCH); raw[bb][p - 1][1] = *(const GAS v4u*)(ub + (size_t)(gg).t * UCW + p * CCH); raw[bb][p - 1][2] = *(const GAS v4u*)(ub + (size_t)tp_ * UCW + p * CCH); } } } while (0)
DI void ph_gate(const Ctx& C, unsigned char* lds_generic, const bf16* U, const float* cw  , const float* cb  , unsigned* ZC, unsigned* X0C, int ch) {
    LAS unsigned* zt = (LAS unsigned*)lds_generic;
    LAS unsigned* xt = zt + 64 * 65;
    LAS float* wl = (LAS float*)(xt + 64 * 65);
    constexpr int NTT = PPOS / 64, NCT = CCH / 64;
    const int tl = C.tid >> 3, c8 = C.tid & 7;
    const bool fastmap = (C.G % NCT) == 0;
    const int nun = fastmap ? NTT / (C.G / NCT) + ((NTT % (C.G / NCT)) ? 1 : 0) : (NTT * NCT + C.G - 1) / C.G;
    int ct_loaded = -1;
    v4u raw[2][2][3];
    { const GateGeom g0 = gate_geom(C, 0, fastmap, tl); if (g0.valid) GATE_LOAD(g0); }
    for (int i = 0; i < nun; ++i) {
        const GateGeom g = gate_geom(C, i, fastmap, tl);
        if (!g.valid) break;
        const int ct = g.ct, ppt = g.ppt, t = g.t, Lq = g.Lq, c0 = ch * CCH + ct * 64;
        __syncthreads();
        if (ct != ct_loaded) { ct_loaded = ct;
            for (int e = C.tid; e < 64 * 12; e += NTHR) { const int c = e / 12, r = e % 12, p = r >> 2, k = r & 3; wl[e] = k < 3 ? cw[(size_t)k * (3 * D) + p * D + c0 + c] : cb[p * D + c0 + c]; }
            __syncthreads(); }
        const float m0 = t > 0 ? 1.f : 0.f, m2 = t < Lq - 1 ? 1.f : 0.f;
#pragma unroll
        for (int e = 0; e < 8; ++e) {
            const f32x4 w1 = *(const LAS f32x4*)(wl + (c8 * 8 + e) * 12 + 4), w2 = *(const LAS f32x4*)(wl + (c8 * 8 + e) * 12 + 8);
            f32x2 zz;
#pragma unroll
            for (int bb = 0; bb < 2; ++bb) {
                float part[3];
#pragma unroll
                for (int p = 1; p < 3; ++p) { const f32x4 w = p == 1 ? w1 : w2;
                    const unsigned a = e < 2 ? raw[bb][p - 1][0].x : e < 4 ? raw[bb][p - 1][0].y : e < 6 ? raw[bb][p - 1][0].z : raw[bb][p - 1][0].w;
                    const unsigned b = e < 2 ? raw[bb][p - 1][1].x : e < 4 ? raw[bb][p - 1][1].y : e < 6 ? raw[bb][p - 1][1].z : raw[bb][p - 1][1].w;
                    const unsigned c = e < 2 ? raw[bb][p - 1][2].x : e < 4 ? raw[bb][p - 1][2].y : e < 6 ? raw[bb][p - 1][2].z : raw[bb][p - 1][2].w;
                    const float ua = (e & 1) ? bf_hi(a) : bf_lo(a), ub_ = (e & 1) ? bf_hi(b) : bf_lo(b), uc = (e & 1) ? bf_hi(c) : bf_lo(c);
                    part[p] = ua * m0 * w.x + ub_ * w.y + uc * m2 * w.z + w.w; }
                const float z = part[2] * part[1];
                if (bb == 0) zz.x = z; else zz.y = z;
            }
            zt[(c8 * 8 + e) * 65 + tl] = pk2(zz.x, zz.y);
        }
        if (i + 1 < nun) { const GateGeom gn = gate_geom(C, i + 1, fastmap, tl); if (gn.valid) GATE_LOAD(gn); }
        __syncthreads();
#pragma unroll
        for (int k = 0; k < 8; ++k) { const int cc = C.wave * 8 + k; const size_t o = (size_t)(ct * 64 + cc) * PPOS + ppt + C.lane; ZC[o] = zt[cc * 65 + C.lane]; }
    }
    __syncthreads();
}
DI void ph_ytrans(const Ctx& C, unsigned char* lds_generic, const unsigned* YC, const bf16* U, const float* cw  , const float* cb  , bf16* AO, int ch) {
    LAS unsigned* tl = (LAS unsigned*)lds_generic;
    LAS float* wl = (LAS float*)(tl + 64 * 65);
    constexpr int NTT = PPOS / 64, NCT = CCH / 64;
    const int pos = C.tid >> 3, c8 = C.tid & 7;
    unsigned v[8]; v4u xr[2][3];
#define YT_LOAD(un_) do { const int ct_ = (un_) % NCT, ppt_ = ((un_) / NCT) * 64; \
        _Pragma("unroll") for (int i = 0; i < 8; ++i) v[i] = YC[(size_t)(ct_ * 64 + C.wave * 8 + i) * PPOS + ppt_ + C.lane]; \
        const int ps_ = ppt_ < LP ? 0 : (ppt_ < 2 * LP ? 1 : 2); int rA_, rB_, Lq_, pp0_; pair_geom(ps_, rA_, rB_, Lq_, pp0_); const int t_ = ppt_ - pp0_ + pos, tm_ = t_ > 0 ? t_ - 1 : 0, tp_ = t_ < Lq_ - 1 ? t_ + 1 : Lq_ - 1; \
        _Pragma("unroll") for (int bb = 0; bb < 2; ++bb) { const bf16* ub = U + (size_t)(bb ? rB_ : rA_) * UCW + ct_ * 64 + c8 * 8; \
            xr[bb][0] = *(const GAS v4u*)(ub + (size_t)tm_ * UCW); xr[bb][1] = *(const GAS v4u*)(ub + (size_t)t_ * UCW); xr[bb][2] = *(const GAS v4u*)(ub + (size_t)tp_ * UCW); } } while (0)
    if (C.vcu < NTT * NCT) YT_LOAD(C.vcu);
    int ct_loaded = -1;
    for (int un = C.vcu; un < NTT * NCT; un += C.G) {
        const int ct = un % NCT, ptile = un / NCT, ppt = ptile * 64;
        const int ps = ppt < LP ? 0 : (ppt < 2 * LP ? 1 : 2);
        int rowA, rowB, Lq, pp0; pair_geom(ps, rowA, rowB, Lq, pp0);
        const int t = ppt - pp0 + pos, c0 = ch * CCH + ct * 64;
        __syncthreads();
        if (ct != ct_loaded) { ct_loaded = ct; if (C.tid < 256) { const int c = C.tid >> 2, k = C.tid & 3; wl[C.tid] = k < 3 ? cw[(size_t)k * (3 * D) + c0 + c] : cb[c0 + c]; } }
#pragma unroll
        for (int i = 0; i < 8; ++i) tl[(C.wave * 8 + i) * 65 + C.lane] = v[i];
        __syncthreads();
        const float m0 = t > 0 ? 1.f : 0.f, m2 = t < Lq - 1 ? 1.f : 0.f;
        float x0p[2][8];
#pragma unroll
        for (int e = 0; e < 8; ++e) { const f32x4 w = *(const LAS f32x4*)(wl + (c8 * 8 + e) * 4);
#pragma unroll
            for (int bb = 0; bb < 2; ++bb) {
                const unsigned a = e < 2 ? xr[bb][0].x : e < 4 ? xr[bb][0].y : e < 6 ? xr[bb][0].z : xr[bb][0].w;
                const unsigned b = e < 2 ? xr[bb][1].x : e < 4 ? xr[bb][1].y : e < 6 ? xr[bb][1].z : xr[bb][1].w;
                const unsigned c = e < 2 ? xr[bb][2].x : e < 4 ? xr[bb][2].y : e < 6 ? xr[bb][2].z : xr[bb][2].w;
                const float ua = (e & 1) ? bf_hi(a) : bf_lo(a), ub_ = (e & 1) ? bf_hi(b) : bf_lo(b), uc = (e & 1) ? bf_hi(c) : bf_lo(c);
                x0p[bb][e] = ua * m0 * w.x + ub_ * w.y + uc * m2 * w.z + w.w; } }
        float ya[8], yb[8];
#pragma unroll
        for (int e = 0; e < 8; ++e) { const unsigned w = tl[(c8 * 8 + e) * 65 + pos]; ya[e] = bf_lo(w) * x0p[0][e]; yb[e] = bf_hi(w) * x0p[1][e]; }
        { const int un2 = un + C.G; if (un2 < NTT * NCT) YT_LOAD(un2); }
        v4u oa, ob; oa.x = pk2(ya[0], ya[1]); oa.y = pk2(ya[2], ya[3]); oa.z = pk2(ya[4], ya[5]); oa.w = pk2(ya[6], ya[7]); ob.x = pk2(yb[0], yb[1]); ob.y = pk2(yb[2], yb[3]); ob.z = pk2(yb[4], yb[5]); ob.w = pk2(yb[6], yb[7]);
        *(GAS v4u*)(AO + (size_t)(rowA + t) * D + c0 + c8 * 8) = oa;
        *(GAS v4u*)(AO + (size_t)(rowB + t) * D + c0 + c8 * 8) = ob;
    }
#undef YT_LOAD
    __syncthreads();
}

typedef f32x2 cf;
DI cf unpk(unsigned w) { return (cf){bf_lo(w), bf_hi(w)}; }
DI cf cmul(cf a, cf b) { return (cf){a.x * b.x - a.y * b.y, a.x * b.y + a.y * b.x}; }
DI cf cis_rev(float rev) { return (cf){__builtin_amdgcn_cosf(rev), __builtin_amdgcn_sinf(rev)}; }
template <bool INV> DI cf rot90(cf a) { return INV ? (cf){-a.y, a.x} : (cf){a.y, -a.x}; }
template <bool INV> DI void dft4(cf& x0, cf& x1, cf& x2, cf& x3) {
    const cf a = x0 + x2, b = x0 - x2, c = x1 + x3, d = rot90<INV>(x1 - x3);
    x0 = a + c; x1 = b + d; x2 = a - c; x3 = b - d;
}
#define FC_C1 0.9238795325112867f
#define FC_S1 0.3826834323650898f
#define FC_H  0.7071067811865476f
template <bool INV> DI cf w16(int k) {
    const float c = k == 0 ? 1.f : k == 1 ? FC_C1 : k == 2 ? FC_H : k == 3 ? FC_S1 : k == 4 ? 0.f : k == 5 ? -FC_S1 : k == 6 ? -FC_H : k == 7 ? -FC_C1 : k == 8 ? -1.f : -FC_C1;
    const float s = k == 0 ? 0.f : k == 1 ? FC_S1 : k == 2 ? FC_H : k == 3 ? FC_C1 : k == 4 ? 1.f : k == 5 ? FC_C1 : k == 6 ? FC_H : k == 7 ? FC_S1 : k == 8 ? 0.f : -FC_S1;
    return (cf){c, INV ? s : -s};
}
template <bool INV> DI void dft_nat(cf (&x)[4]) { dft4<INV>(x[0], x[1], x[2], x[3]); }
template <bool INV> DI void dft_nat(cf (&x)[8]) {
    cf a0 = x[0], a1 = x[2], a2 = x[4], a3 = x[6]; dft4<INV>(a0, a1, a2, a3);
    cf b0 = x[1], b1 = x[3], b2 = x[5], b3 = x[7]; dft4<INV>(b0, b1, b2, b3);
    b1 = cmul(b1, w16<INV>(2)); b2 = rot90<INV>(b2); b3 = cmul(b3, w16<INV>(6));
    x[0] = a0 + b0; x[4] = a0 - b0; x[1] = a1 + b1; x[5] = a1 - b1; x[2] = a2 + b2; x[6] = a2 - b2; x[3] = a3 + b3; x[7] = a3 - b3;
}
template <bool INV> DI void dft_nat(cf (&x)[16]) {
    cf a[4][4];
#pragma unroll
    for (int j1 = 0; j1 < 4; ++j1) { a[j1][0] = x[j1]; a[j1][1] = x[j1 + 4]; a[j1][2] = x[j1 + 8]; a[j1][3] = x[j1 + 12]; dft4<INV>(a[j1][0], a[j1][1], a[j1][2], a[j1][3]); }
#pragma unroll
    for (int j1 = 1; j1 < 4; ++j1)
#pragma unroll
        for (int m = 1; m < 4; ++m) a[j1][m] = cmul(a[j1][m], w16<INV>(j1 * m));
#pragma unroll
    for (int m = 0; m < 4; ++m) { dft4<INV>(a[0][m], a[1][m], a[2][m], a[3][m]); x[m] = a[0][m]; x[m + 4] = a[1][m]; x[m + 8] = a[2][m]; x[m + 12] = a[3][m]; }
}
template <int R, bool INV> DI void twiddle(cf (&x)[R], float rev) {
    asm volatile("" : "+v"(rev));
    cf w[R];
    w[1] = cis_rev(INV ? rev : -rev);
#pragma unroll
    for (int m = 2; m < R; ++m) w[m] = (m & 1) ? cmul(w[m - 1], w[1]) : cmul(w[m >> 1], w[m >> 1]);
#pragma unroll
    for (int m = 1; m < R; ++m) x[m] = cmul(x[m], w[m]);
}
DI int pidx(int i) { return i + ((i >> 6) << 2); }
constexpr int TW_OFF = 17408;
template <int N> DI constexpr int tw_base() { return N == 1024 ? TW_OFF : (N == 64 ? TW_OFF + 1024 : TW_OFF + 1024 + 64); }
template <int N> DI constexpr bool tw_has() { return N == 1024 || N == 64 || N == 128; }
typedef LAS cf* ldscf;
template <int S> DI constexpr int poff(int m) { return m * S + (((m * S) >> 6) << 2); }
#define FFT_OPAQUE(v) asm volatile("" : "+v"(v))
#define FFT_ULOOP(T, R) constexpr int NB_ = (T) / (R), NI_ = NB_ >= NTHR ? NB_ / NTHR : 1; _Pragma("unroll") for (int i_ = 0; i_ < NI_; ++i_) if (NB_ >= NTHR || tid < NB_)
template <int T, int N, int R, bool INV> DI void fft_pass_lds(ldscf lds, int tid) {
    constexpr int S = N / R, NB = T / R, NI = NB >= NTHR ? NB / NTHR : 1;
    if (NB < NTHR && tid >= NB) return;
    cf x[NI][R], w[NI][R]; int p0[NI], kk[NI];
#pragma unroll
    for (int i = 0; i < NI; ++i) { const int u = tid + NTHR * i, b = u / S, k = u % S; kk[i] = k; p0[i] = pidx(b * N + k); FFT_OPAQUE(p0[i]); int tk = tw_base<N>() + k; FFT_OPAQUE(tk);
#pragma unroll
        for (int m = 0; m < R; ++m) x[i][m] = lds[p0[i] + poff<S>(m)];
        if constexpr (tw_has<N>()) {
#pragma unroll
            for (int m = 1; m < R; ++m) w[i][m] = lds[tk + m * S]; } }
    __builtin_amdgcn_sched_barrier(0);
#pragma unroll
    for (int i = 0; i < NI; ++i) {
        if (!INV) { dft_nat<false>(x[i]);
            if constexpr (tw_has<N>()) {
#pragma unroll
                for (int m = 1; m < R; ++m) x[i][m] = cmul(x[i][m], w[i][m]);
            } else if (N != R) twiddle<R, false>(x[i], (float)kk[i] * (1.0f / N)); }
        else {
            if constexpr (tw_has<N>()) {
#pragma unroll
                for (int m = 1; m < R; ++m) x[i][m] = cmul(x[i][m], (cf){w[i][m].x, -w[i][m].y});
            } else if (N != R) twiddle<R, true>(x[i], (float)kk[i] * (1.0f / N));
            dft_nat<true>(x[i]); } }
#pragma unroll
    for (int i = 0; i < NI; ++i)
#pragma unroll
        for (int m = 0; m < R; ++m) lds[p0[i] + poff<S>(m)] = x[i][m];
}
#ifndef LAST_PD
#define LAST_PD 2
#endif
#ifndef FFT_REP_S
#define FFT_REP_S 1
#endif
#ifndef FFT_REP_P
#define FFT_REP_P 1
#endif
#ifndef FFTX_PROMPT
#define FFTX_PROMPT 8
#endif
#ifndef FFTX_MID
#define FFTX_MID 1
#endif
#ifndef FFTX_FIRST
#define FFTX_FIRST 1
#endif
#ifndef FFT_PROBE_FIRST
#define FFT_PROBE_FIRST 0
#endif
#ifndef FFT_PROBE_LAST
#define FFT_PROBE_LAST 0
#endif
#ifndef FFT_PROBE_MID
#define FFT_PROBE_MID 0
#endif
#define FFT_PROBE_SCALE (FFT_PROBE_MID == 1 ? 1.0f / 256.0f : 1.0f / 65536.0f)
constexpr int FA_OFF = TW_OFF + 16 * (64 + 4 + 8);
DI float fft_cos16(int n) { const int r = n & 7; const float b = r == 0 ? 1.f : r == 1 ? FC_C1 : r == 2 ? FC_H : r == 3 ? FC_S1 : r == 4 ? 0.f : r == 5 ? -FC_S1 : r == 6 ? -FC_H : -FC_C1; return (n & 8) ? -b : b; }
DI void fft_build_amat(ldscf A, int tid) {
    if (tid < 64) { const int m = tid & 31, h = tid >> 5, half = m >> 4, mm = m & 15, o = (mm & 3) | (((mm >> 3) & 1) << 2) | (((mm >> 2) & 1) << 3);
        float a0[8], a1[8];
#pragma unroll
        for (int j = 0; j < 8; ++j) { const int n = (o * (8 * h + j)) & 15; const float c = fft_cos16(n), sn = fft_cos16(n - 4); a0[j] = half ? -sn : c; a1[j] = half ? c : sn; }
        v4u h0, l0, h1, l1;
#pragma unroll
        for (int q = 0; q < 4; ++q) { const unsigned w0 = pk2(a0[2 * q], a0[2 * q + 1]), w1 = pk2(a1[2 * q], a1[2 * q + 1]);
            h0[q] = w0; l0[q] = pk2(a0[2 * q] - bf_lo(w0), a0[2 * q + 1] - bf_hi(w0)); h1[q] = w1; l1[q] = pk2(a1[2 * q] - bf_lo(w1), a1[2 * q + 1] - bf_hi(w1)); }
        LAS v4u* t = (LAS v4u*)(A + FA_OFF);
        t[tid] = h0; t[64 + tid] = l0; t[128 + tid] = h1; t[192 + tid] = l1; }
}
template <bool INV> DI void fft_mfma16(const cf (&x)[8], cf (&y)[8], const bf16x8 (&am)[4]) {
    v4u re, im;
#pragma unroll
    for (int q = 0; q < 4; ++q) { re[q] = pk2(x[2 * q].x, x[2 * q + 1].x); im[q] = pk2(x[2 * q].y, x[2 * q + 1].y); }
    const bf16x8 b0 = __builtin_bit_cast(bf16x8, INV ? im : re), b1 = __builtin_bit_cast(bf16x8, INV ? re : im);
    f32x16 acc;
#pragma unroll
    for (int i = 0; i < 16; ++i) acc[i] = 0.f;
    acc = __builtin_amdgcn_mfma_f32_32x32x16_bf16(am[0], b0, acc, 0, 0, 0);
    acc = __builtin_amdgcn_mfma_f32_32x32x16_bf16(am[2], b1, acc, 0, 0, 0);
    acc = __builtin_amdgcn_mfma_f32_32x32x16_bf16(am[1], b0, acc, 0, 0, 0);
    acc = __builtin_amdgcn_mfma_f32_32x32x16_bf16(am[3], b1, acc, 0, 0, 0);
#pragma unroll
    for (int j = 0; j < 8; ++j) y[j] = INV ? (cf){acc[8 + j], acc[j]} : (cf){acc[j], acc[8 + j]};
}
DI void fft_load_amat(ldscf lds, int lane, bf16x8 (&am)[4]) {
    int fo = FA_OFF * 2 + lane * 4; FFT_OPAQUE(fo);
    const LAS unsigned* t = (const LAS unsigned*)lds + fo;
#pragma unroll
    for (int q = 0; q < 4; ++q) am[q] = __builtin_bit_cast(bf16x8, *(const LAS v4u*)(t + q * 256));
}
template <int T, int N, bool INV> DI void fft_pass_mfma(ldscf lds, int tid) {
    constexpr int S = N / 16, NI = T / 16 / NTHR, NW = S > 32 ? 2 : 1;
    static_assert(NI >= 1 && tw_has<N>() && S <= 64, "table twiddles only");
    const int lane = tid & 63, h = lane >> 5, c = lane & 31, wb = tid & ~63;
    bf16x8 am[4]; fft_load_amat(lds, lane, am);
    cf x[NI][2][8], w[NW][8]; int p0[NI][2];
#pragma unroll
    for (int i = 0; i < NI; ++i)
#pragma unroll
        for (int cb = 0; cb < 2; ++cb) { const int u = wb + 32 * cb + c + NTHR * i, b = u / S, k = u % S; p0[i][cb] = pidx(b * N + k) + h * poff<S>(8); FFT_OPAQUE(p0[i][cb]);
#pragma unroll
            for (int j = 0; j < 8; ++j) x[i][cb][j] = lds[p0[i][cb] + poff<S>(j)];
            if (i == 0 && cb < NW) { int tk = tw_base<N>() + k + 8 * h * S; FFT_OPAQUE(tk);
#pragma unroll
                for (int j = 0; j < 8; ++j) w[cb][j] = lds[tk + j * S]; } }
    __builtin_amdgcn_sched_barrier(0);
#pragma unroll
    for (int i = 0; i < NI; ++i)
#pragma unroll
        for (int cb = 0; cb < 2; ++cb) { cf y[8]; const int wi = cb < NW ? cb : 0;
            if (INV) {
#pragma unroll
                for (int j = 0; j < 8; ++j) x[i][cb][j] = cmul(x[i][cb][j], (cf){w[wi][j].x, -w[wi][j].y}); }
            fft_mfma16<INV>(x[i][cb], y, am);
#pragma unroll
            for (int j = 0; j < 8; ++j) lds[p0[i][cb] + poff<S>(j)] = INV ? y[j] : cmul(y[j], w[wi][j]); }
}
template <int T, int N, int R, class Gen> DI void fft_first_fwd(ldscf lds, int tid, const Gen& gen) {
    constexpr int S = N / R, NB = T / R, NI = NB >= NTHR ? NB / NTHR : 1;
    if (NB < NTHR && tid >= NB) return;
    typename Gen::Pre pre[NI][R]; int bs[NI];
#pragma unroll
    for (int i = 0; i < NI; ++i) { const int u = tid + NTHR * i, b = u / S, k = u % S; bs[i] = b * N + k; FFT_OPAQUE(bs[i]); }
    constexpr bool AHEAD = FFTX_FIRST && sizeof(typename Gen::Pre) <= 4;
#pragma unroll
    for (int m = 0; m < R; ++m) pre[0][m] = gen.pre(bs[0] + m * S);
#pragma unroll
    for (int i = 0; i < NI; ++i) { const int base = bs[i], p0 = pidx(base), k = base % S;
        if (!AHEAD && i > 0) {
#pragma unroll
            for (int m = 0; m < R; ++m) pre[i][m] = gen.pre(base + m * S); }
        cf x[R];
#pragma unroll
        for (int m = 0; m < R; ++m) x[m] = gen(base + m * S, pre[i][m]);
        if (AHEAD && i + 1 < NI) {
#pragma unroll
            for (int m = 0; m < R; ++m) pre[i + 1][m] = gen.pre(bs[i + 1] + m * S); }
        dft_nat<false>(x); twiddle<R, false>(x, (float)k * (1.0f / N));
#pragma unroll
        for (int m = 0; m < R; ++m) lds[p0 + poff<S>(m)] = x[m];
    }
}
template <int R, int NI> DI void fft_last_fwd(ldscf lds, int tid, cf (&res)[NI][R]) {
#pragma unroll
    for (int i = 0; i < NI; ++i) { int p0 = pidx((tid + NTHR * i) * R); FFT_OPAQUE(p0);
#pragma unroll
        for (int m = 0; m < R; ++m) res[i][m] = lds[p0 + m];
        dft_nat<false>(res[i]); }
}
template <int R, int NI> DI void fft_first_inv(ldscf lds, int tid, cf (&res)[NI][R]) {
#pragma unroll
    for (int i = 0; i < NI; ++i) { int p0 = pidx((tid + NTHR * i) * R); FFT_OPAQUE(p0); dft_nat<true>(res[i]);
#pragma unroll
        for (int m = 0; m < R; ++m) lds[p0 + m] = res[i][m]; }
}
template <int T, int N, int R, class Out> DI void fft_last_inv(ldscf lds, int tid, const Out& out) {
    constexpr int S = N / R, NB = T / R, NI = NB >= NTHR ? NB / NTHR : 1;
    if (NB < NTHR && tid >= NB) return;
    typename Out::Pre pre[NI][R]; int bs[NI];
#pragma unroll
    for (int i = 0; i < NI; ++i) { const int u = tid + NTHR * i, b = u / S, k = u % S; bs[i] = b * N + k; FFT_OPAQUE(bs[i]); }
#pragma unroll
    for (int m = 0; m < R; ++m) pre[0][m] = out.pre(bs[0] + m * S);
#pragma unroll
    for (int i = 0; i < NI; ++i) { const int base = bs[i], p0 = pidx(base), k = base % S;
        cf x[R];
#pragma unroll
        for (int m = 0; m < R; ++m) x[m] = lds[p0 + poff<S>(m)];
        twiddle<R, true>(x, (float)k * (1.0f / N)); dft_nat<true>(x);
        if (i + 1 < NI) {
#pragma unroll
            for (int m = 0; m < R; ++m) pre[i + 1][m] = out.pre(bs[i + 1] + m * S); }
#pragma unroll
        for (int m = 0; m < R; ++m) out(base + m * S, x[m], pre[i][m]);
    }
}
template <bool INV> DI void twiddle_h(cf (&y)[8], float rev, int h) {
    asm volatile("" : "+v"(rev));
    const cf w1 = cis_rev(INV ? rev : -rev), w2 = cmul(w1, w1), w3 = cmul(w2, w1), w4 = cmul(w2, w2), w5 = cmul(w4, w1), w6 = cmul(w3, w3), w7 = cmul(w4, w3), w8 = cmul(w4, w4);
    const cf bs = h ? w8 : (cf){1.f, 0.f};
    y[0] = cmul(y[0], bs); y[1] = cmul(y[1], cmul(bs, w1)); y[2] = cmul(y[2], cmul(bs, w2)); y[3] = cmul(y[3], cmul(bs, w3));
    y[4] = cmul(y[4], cmul(bs, w4)); y[5] = cmul(y[5], cmul(bs, w5)); y[6] = cmul(y[6], cmul(bs, w6)); y[7] = cmul(y[7], cmul(bs, w7));
}
template <int T, int N, class Gen> DI void fft_first_fwd_m(ldscf lds, int tid, const Gen& gen) {
    constexpr int S = N / 16, NBLK = 2 * (T / 16 / NTHR);
    static_assert(T / 16 >= NTHR, "one butterfly set per thread at least");
    const int lane = tid & 63, h = lane >> 5, c = lane & 31, wb = tid & ~63;
    bf16x8 am[4]; fft_load_amat(lds, lane, am);
    typename Gen::Pre pre[NBLK][8]; int bs[NBLK];
#pragma unroll
    for (int q = 0; q < NBLK; ++q) { const int u = wb + 32 * (q & 1) + c + NTHR * (q >> 1), b = u / S, k = u % S; bs[q] = b * N + k; FFT_OPAQUE(bs[q]); }
#pragma unroll
    for (int q = 0; q < NBLK; ++q)
#pragma unroll
        for (int j = 0; j < 8; ++j) pre[q][j] = gen.pre(bs[q] + (8 * h + j) * S);
#pragma unroll
    for (int q = 0; q < NBLK; ++q) { const int base = bs[q], k = base % S, p0 = pidx(base) + h * poff<S>(8);
        cf x[8], y[8];
#pragma unroll
        for (int j = 0; j < 8; ++j) x[j] = gen(base + (8 * h + j) * S, pre[q][j]);
        fft_mfma16<false>(x, y, am);
        twiddle_h<false>(y, (float)k * (1.0f / N), h);
#pragma unroll
        for (int j = 0; j < 8; ++j) lds[p0 + poff<S>(j)] = y[j];
    }
}
template <int T, int N, class Out> DI void fft_last_inv_m(ldscf lds, int tid, const Out& out) {
    constexpr int S = N / 16, NBLK = 2 * (T / 16 / NTHR);
    static_assert(T / 16 >= NTHR, "one butterfly set per thread at least");
    const int lane = tid & 63, h = lane >> 5, c = lane & 31, wb = tid & ~63;
    bf16x8 am[4]; fft_load_amat(lds, lane, am);
    constexpr int PD = LAST_PD < NBLK ? LAST_PD : NBLK;
    typename Out::Pre pre[NBLK][8]; int bs[NBLK];
#pragma unroll
    for (int q = 0; q < NBLK; ++q) { const int u = wb + 32 * (q & 1) + c + NTHR * (q >> 1), b = u / S, k = u % S; bs[q] = b * N + k; FFT_OPAQUE(bs[q]); }
#pragma unroll
    for (int q = 0; q < PD; ++q)
#pragma unroll
        for (int j = 0; j < 8; ++j) pre[q][j] = out.pre(bs[q] + (8 * h + j) * S);
#pragma unroll
    for (int q = 0; q < NBLK; ++q) { const int base = bs[q], k = base % S, p0 = pidx(base) + h * poff<S>(8);
        cf x[8], y[8];
#pragma unroll
        for (int j = 0; j < 8; ++j) x[j] = lds[p0 + poff<S>(j)];
        twiddle_h<true>(x, (float)k * (1.0f / N), h);
        fft_mfma16<true>(x, y, am);
        if (q + PD < NBLK) {
#pragma unroll
            for (int j = 0; j < 8; ++j) pre[q + PD][j] = out.pre(bs[q + PD] + (8 * h + j) * S); }
#pragma unroll
        for (int j = 0; j < 8; ++j) out(base + (8 * h + j) * S, y[j], pre[q][j]);
    }
}
struct GenZS { const unsigned* z; int half; typedef unsigned Pre; DI Pre pre(int e) const { return z[e]; }
    DI cf operator()(int e, Pre w) const { const cf v = unpk(w); if (!half) return v; return cmul(v, cis_rev(-(float)e * (1.0f / (2 * LS)))); } };
struct OutOddS { unsigned* scr; struct Pre {}; DI Pre pre(int) const { return Pre{}; } DI void operator()(int e, cf v, Pre) const { const cf r = cmul(v, cis_rev((float)e * (1.0f / (2 * LS)))); scr[e] = pk2(r.x, r.y); } };
struct OutEvenS { const unsigned* scr; unsigned* yc;
    struct Pre { unsigned so; };
    DI Pre pre(int e) const { Pre p; p.so = __hip_atomic_load(scr + e, __ATOMIC_RELAXED, __HIP_MEMORY_SCOPE_AGENT); return p; }
    DI void operator()(int e, cf v, Pre p) const { const cf y = v + unpk(p.so); yc[e] = pk2(y.x, y.y); } };

DI void fft_last_fwd_store(ldscf lds, int tid, unsigned* kfs) {
    for (int i = 0; i < 8; ++i) { int base = 1024 * ((tid >> 6) + 8 * (i >> 2)) + 4 * ((tid & 63) + 64 * (i & 3)); FFT_OPAQUE(base); const int p0 = pidx(base); cf x[4];
        const f32x4 a = *(const LAS f32x4*)(lds + p0), b = *(const LAS f32x4*)(lds + p0 + 2);
        x[0] = (cf){a.x, a.y}; x[1] = (cf){a.z, a.w}; x[2] = (cf){b.x, b.y}; x[3] = (cf){b.z, b.w};
        dft_nat<false>(x);
        v4u kw; kw.x = pk2(x[0].x, x[0].y); kw.y = pk2(x[1].x, x[1].y); kw.z = pk2(x[2].x, x[2].y); kw.w = pk2(x[3].x, x[3].y); *(GAS v4u*)(kfs + base) = kw; }
}
DI void fft_mid_mul(ldscf lds, int tid, const unsigned* kfs) {
    int base0 = 1024 * (tid >> 6) + 4 * (tid & 63); FFT_OPAQUE(base0);
    v4u kw[8];
#pragma unroll
    for (int i = 0; i < 8; ++i) if (FFTX_MID) kw[i] = __builtin_nontemporal_load((const GAS v4u*)(kfs + base0 + 8192 * (i >> 2) + 256 * (i & 3)));
#pragma unroll
    for (int i = 0; i < 8; ++i) { if (!FFTX_MID) kw[i] = __builtin_nontemporal_load((const GAS v4u*)(kfs + base0 + 8192 * (i >> 2) + 256 * (i & 3))); const int p0 = pidx(base0) + (8192 + 512) * (i >> 2) + (256 + 16) * (i & 3); cf x[4];
        const f32x4 a = *(const LAS f32x4*)(lds + p0), b = *(const LAS f32x4*)(lds + p0 + 2);
        x[0] = (cf){a.x, a.y}; x[1] = (cf){a.z, a.w}; x[2] = (cf){b.x, b.y}; x[3] = (cf){b.z, b.w};
        dft_nat<false>(x);
        x[0] = cmul(x[0], unpk(kw[i].x)); x[1] = cmul(x[1], unpk(kw[i].y)); x[2] = cmul(x[2], unpk(kw[i].z)); x[3] = cmul(x[3], unpk(kw[i].w));
#if FFT_PROBE_MID
        for (int m = 0; m < 4; ++m) x[m] = x[m] * FFT_PROBE_SCALE;
#endif
        dft_nat<true>(x);
        *(LAS f32x4*)(lds + p0) = (f32x4){x[0].x, x[0].y, x[1].x, x[1].y}; *(LAS f32x4*)(lds + p0 + 2) = (f32x4){x[2].x, x[2].y, x[3].x, x[3].y}; }
}
DI int fft_rho(int k) { return ((k & 15) << 10) | (((k >> 4) & 15) << 6) | (((k >> 8) & 15) << 2) | (k >> 12); }
DI int fft_rho_inv(int p) { return (p >> 10) | (((p >> 6) & 15) << 4) | (((p >> 2) & 15) << 8) | ((p & 3) << 12); }
struct GenK2S { const unsigned* hfp; const unsigned* hbp; int half; float skA, skB;
    struct Pre { unsigned f, b; };
    DI Pre pre(int e) const { Pre p; p.f = hfp[e]; p.b = e ? hbp[LS - e] : 0u; return p; }
    DI cf operator()(int e, Pre p) const { float aA = bf_lo(p.f), aB = bf_hi(p.f); const float bA = bf_lo(p.b), bB = bf_hi(p.b);
        if (e == 0) { aA += skA; aB += skB; }
        if (!half) return (cf){aA + bA, aB + bB};
        return cmul((cf){aA - bA, aB - bB}, cis_rev(-(float)e * (1.0f / (2 * LS)))); } };
DI void fft_r4_inplace(ldscf lds, int tid) {
    for (int i = 0; i < 8; ++i) { int base = 1024 * ((tid >> 6) + 8 * (i >> 2)) + 4 * ((tid & 63) + 64 * (i & 3)); FFT_OPAQUE(base); const int p0 = pidx(base); cf x[4];
        const f32x4 a = *(const LAS f32x4*)(lds + p0), b = *(const LAS f32x4*)(lds + p0 + 2);
        x[0] = (cf){a.x, a.y}; x[1] = (cf){a.z, a.w}; x[2] = (cf){b.x, b.y}; x[3] = (cf){b.z, b.w};
        dft_nat<false>(x);
        *(LAS f32x4*)(lds + p0) = (f32x4){x[0].x, x[0].y, x[1].x, x[1].y}; *(LAS f32x4*)(lds + p0 + 2) = (f32x4){x[2].x, x[2].y, x[3].x, x[3].y}; }
}
DI void fft_kernel_separate(ldscf lds, int tid, int half, unsigned* kfA, unsigned* kfB) {
    for (int i = 0; i < 8; ++i) { int base = 1024 * ((tid >> 6) + 8 * (i >> 2)) + 4 * ((tid & 63) + 64 * (i & 3)); FFT_OPAQUE(base); const int p0 = pidx(base);
        const f32x4 a = *(const LAS f32x4*)(lds + p0), b = *(const LAS f32x4*)(lds + p0 + 2);
        const cf u[4] = {(cf){a.x, a.y}, (cf){a.z, a.w}, (cf){b.x, b.y}, (cf){b.z, b.w}};
        unsigned wa[4], wb[4];
#pragma unroll
        for (int m = 0; m < 4; ++m) { const int k = fft_rho_inv(base + m), kp = half ? (LS - 1 - k) : ((LS - k) & (LS - 1)); cf v = lds[pidx(fft_rho(kp))]; v.y = -v.y;
            const cf ka = (u[m] + v) * 0.5f, dd = u[m] - v; wa[m] = pk2(ka.x, ka.y); wb[m] = pk2(dd.y * 0.5f, -dd.x * 0.5f); }
        *(GAS v4u*)(kfA + base) = (v4u){wa[0], wa[1], wa[2], wa[3]}; *(GAS v4u*)(kfB + base) = (v4u){wb[0], wb[1], wb[2], wb[3]}; }
}
struct SampleChan { const unsigned* z; const unsigned* x0; unsigned* yc; float skip; };
DI void fft_unit_sample2(int tid, ldscf A, const unsigned* hfp, const unsigned* hbp, SampleChan cA, SampleChan cB, unsigned* scr) {
    unsigned* const kfA = scr + 2 * LS; unsigned* const kfB = scr + 3 * LS;
#define FFT_WSYNC() asm volatile("s_waitcnt lgkmcnt(0)" ::: "memory")
    for (int half = 1; half >= 0; --half) {
        __syncthreads();
        fft_first_fwd_m<LS, LS>(A, tid, GenK2S{hfp, hbp, half, cA.skip * (1.0f / (2 * LS)), cB.skip * (1.0f / (2 * LS))}); __syncthreads();
        fft_pass_mfma<LS, 1024, false>(A, tid); FFT_WSYNC();
        fft_pass_mfma<LS, 64, false>(A, tid); FFT_WSYNC();
        fft_r4_inplace(A, tid); __syncthreads();
        fft_kernel_separate(A, tid, half, kfA, kfB);
        for (int ch = 0; ch < 2; ++ch) {
            const SampleChan c = ch ? cB : cA; unsigned* const uo = scr + ch * LS; const unsigned* const kfs = ch ? kfB : kfA;
            __syncthreads();
            fft_first_fwd_m<LS, LS>(A, tid, GenZS{c.z, half}); __syncthreads();
#if FFT_PROBE_FIRST
            fft_first_fwd_m<LS, LS>(A, tid, GenZS{c.z, half}); __syncthreads();
#endif
            fft_pass_mfma<LS, 1024, false>(A, tid); FFT_WSYNC();
            fft_pass_mfma<LS, 64, false>(A, tid); FFT_WSYNC();
#if FFT_PROBE_MID
            for (int pr = 0; pr < FFT_PROBE_MID; ++pr) { fft_pass_mfma<LS, 64, true>(A, tid); FFT_WSYNC(); fft_pass_mfma<LS, 1024, true>(A, tid); FFT_WSYNC(); fft_pass_mfma<LS, 1024, false>(A, tid); FFT_WSYNC(); fft_pass_mfma<LS, 64, false>(A, tid); FFT_WSYNC(); }
#endif
            fft_mid_mul(A, tid, kfs); FFT_WSYNC();
            fft_pass_mfma<LS, 64, true>(A, tid); FFT_WSYNC();
            fft_pass_mfma<LS, 1024, true>(A, tid); __syncthreads();
            if (half) fft_last_inv_m<LS, LS>(A, tid, OutOddS{uo});
            else fft_last_inv_m<LS, LS>(A, tid, OutEvenS{uo, c.yc});
#if FFT_PROBE_LAST
            if (half) { if (FFT_PROBE_LAST != 3) fft_last_inv<LS, LS, 16>(A, tid, OutOddS{uo}); }
            else if (FFT_PROBE_LAST != 2) fft_last_inv<LS, LS, 16>(A, tid, OutEvenS{uo, c.yc});
#endif
        }
    }
}
struct GenKP2 { const unsigned* hfp; const unsigned* hbp; float sk0, sk1; struct Pre { unsigned f, b; };
    DI Pre pre(int e) const { const int j = e & (LP - 1); Pre p; p.f = hfp[j]; p.b = j ? hbp[LP - j] : 0u; return p; }
    DI cf operator()(int e, Pre p) const { const int kidx = e >> 11, half = kidx & 1, ch = kidx >> 1, j = e & (LP - 1); float A = ch ? bf_hi(p.f) : bf_lo(p.f); const float B = ch ? bf_hi(p.b) : bf_lo(p.b);
        if (j == 0) A += ch ? sk1 : sk0;
        if (!half) return (cf){A + B, 0.f}; return (A - B) * cis_rev(-(float)j * (1.0f / (2 * LP))); } };
struct GenZP2 { const unsigned* z; typedef unsigned Pre;
    DI Pre pre(int e) const { const int f = e >> 11, ch = (f >> 1) & 1, pair = f >> 2, j = e & (LP - 1); return z[(size_t)ch * PPOS + pair * LP + j]; }
    DI cf operator()(int e, Pre w) const { const int half = (e >> 11) & 1, j = e & (LP - 1); const cf v = unpk(w); if (!half) return v; return cmul(v, cis_rev(-(float)j * (1.0f / (2 * LP)))); } };
DI void fft_unit_prompt2(int tid, ldscf A, const unsigned* hf, const unsigned* hb, const unsigned* z, const unsigned* x0, float skip0, float skip1, unsigned* yc) {
    cf kf[2][8], d[4][8];
    __syncthreads();
    fft_first_fwd_m<4 * LP, LP>(A, tid, GenKP2{hf, hb, skip0 * (1.0f / (2 * LP)), skip1 * (1.0f / (2 * LP))}); __syncthreads();
    fft_pass_mfma<4 * LP, 128, false>(A, tid); __syncthreads();
    fft_last_fwd<8, 2>(A, tid, kf); __syncthreads();
    fft_first_fwd_m<8 * LP, LP>(A, tid, GenZP2{z}); __syncthreads();
    fft_pass_mfma<8 * LP, 128, false>(A, tid); __syncthreads();
    fft_last_fwd<8, 4>(A, tid, d);
#pragma unroll
    for (int i = 0; i < 4; ++i)
#pragma unroll
        for (int m = 0; m < 8; ++m) d[i][m] = cmul(d[i][m], kf[i & 1][m]);
    fft_first_inv<8, 4>(A, tid, d); __syncthreads();
    fft_pass_mfma<8 * LP, 128, true>(A, tid); __syncthreads();
    fft_pass_lds<8 * LP, LP, 16, true>(A, tid); __syncthreads();
#if FFTX_PROMPT
    constexpr int PB_ = FFTX_PROMPT;
#pragma unroll 1
    for (int qq = 0; qq < 16 / PB_; ++qq) { int tq = tid + NTHR * PB_ * qq; FFT_OPAQUE(tq);
#pragma unroll
        for (int q = 0; q < PB_; ++q) { const int idx = tq + NTHR * q, ch = idx >> 12, pair = (idx >> 11) & 1, t = idx & (LP - 1), fe = 2 * ch + 4 * pair;
            const cf ue = A[pidx(fe * LP + t)], uo = A[pidx((fe + 1) * LP + t)];
            const size_t gi = (size_t)ch * PPOS + pair * LP + t;
            const cf y = (ue + cmul(uo, cis_rev((float)t * (1.0f / (2 * LP)))));
            yc[gi] = pk2(y.x, y.y); }
    }
#else
    for (int idx = tid; idx < 4 * LP; idx += NTHR) {
        const int ch = idx >> 12, pair = (idx >> 11) & 1, t = idx & (LP - 1), fe = 2 * ch + 4 * pair;
        const cf ue = A[pidx(fe * LP + t)], uo = A[pidx((fe + 1) * LP + t)];
        const size_t gi = (size_t)ch * PPOS + pair * LP + t;
        const cf y = (ue + cmul(uo, cis_rev((float)t * (1.0f / (2 * LP)))));
        yc[gi] = pk2(y.x, y.y);
    }
#endif
}
DI void ph_fft(const Ctx& C, unsigned char* lds_generic, const unsigned* HT, const unsigned* ZC, const unsigned* X0C, unsigned* YC, const float* skipv  , unsigned* scr_all, int ch) {
    ldscf A = (ldscf)lds_generic;
    unsigned* scr = scr_all + (size_t)blockIdx.x * (4 * LS);
    for (int e = C.tid; e < 16 * (64 + 4 + 8); e += NTHR) {
        int m, k, n; if (e < 1024) { m = e >> 6; k = e & 63; n = 1024; } else if (e < 1024 + 64) { m = (e - 1024) >> 2; k = e & 3; n = 64; } else { m = (e - 1088) >> 3; k = (e - 1088) & 7; n = 128; }
        A[TW_OFF + e] = cis_rev(-(float)(k * m) / (float)n); }
    fft_build_amat(A, C.tid);
    __syncthreads();
    for (int un = C.vcu; un < CCH; un += C.G) {
        const int cl = 2 * (un < CCH / 2 ? un : un - CCH / 2);
        const unsigned* hf = HT + (size_t)cl * NPOS; const unsigned* hb = hf + NPOS;
        if (un < CCH / 2) {
            const size_t o0 = (size_t)cl * PPOS + 2 * LP, o1 = o0 + PPOS;
            for (int rp_ = 0; rp_ < FFT_REP_S; ++rp_) fft_unit_sample2(C.tid, A, hf + LP, hb + LP, SampleChan{ZC + o0, X0C + o0, YC + o0, skipv[ch * CCH + cl]}, SampleChan{ZC + o1, X0C + o1, YC + o1, skipv[ch * CCH + cl + 1]}, scr);
        } else for (int rp_ = 0; rp_ < FFT_REP_P; ++rp_) fft_unit_prompt2(C.tid, A, hf, hb, ZC + (size_t)cl * PPOS, X0C + (size_t)cl * PPOS, skipv[ch * CCH + cl], skipv[ch * CCH + cl + 1], YC + (size_t)cl * PPOS);
    }
    __syncthreads();
}

#ifndef REP_G
#define REP_G 1
#endif
#ifndef REP_E
#define REP_E 1
#endif
#ifndef REP_A
#define REP_A 1
#endif
#ifndef REP_R
#define REP_R 1
#endif
#ifndef REP_N
#define REP_N REP_E
#endif
#ifndef REP_F
#define REP_F REP_E
#endif
#ifndef REP_H
#define REP_H REP_E
#endif
#ifndef MK_P2_SPLIT
#define MK_P2_SPLIT 0
#endif
#ifndef XB_EXTRA
#define XB_EXTRA 0
#endif
#ifndef REP_FH
#define REP_FH 1
#endif
#ifndef REP_HG
#define REP_HG 1
#endif
#ifndef REP_HF
#define REP_HF 1
#endif
#ifndef REP_4
#define REP_4 REP_E
#endif
#ifndef MK_LAUNCH_PER_STEP
#define MK_LAUNCH_PER_STEP 0
#endif
struct Args { const float* in[25]; float* out; unsigned char* ws; int step_lo, step_hi; };
constexpr int NSTEPS = (DEPTH / 2) * ((1 + 3 * NHC + 1 + NMLPC + 1) + (1 + 4 * NCH + 1 + NMLPC + 1));

#ifndef MK_LB
#define MK_LB 2
#endif
#ifndef MK_LBT
#define MK_LBT NTHR
#endif
__global__ void __launch_bounds__(MK_LBT, MK_LB) mega_fwd(Args args) {
    extern __shared__ __attribute__((aligned(16))) unsigned char lds[];
    Ctx C0;
    C0.tid = threadIdx.x; C0.lane = C0.tid & 63; C0.wave = __builtin_amdgcn_readfirstlane(C0.tid >> 6);
    C0.G = gridDim.x; { const int bx = blockIdx.x; C0.vcu = (C0.G % 8 == 0) ? (bx % 8) * (C0.G / 8) + bx / 8 : bx; }
    C0.gw = C0.vcu * NWAVES + C0.wave; C0.NGW = C0.G * NWAVES;
    LAS unsigned char* ldsl = (LAS unsigned char*)lds;
    volatile LAS unsigned* MISC = (volatile LAS unsigned*)(ldsl + MISC_OFF);
    for (int u = C0.tid; u < (LDS_BYTES - LDSCTL_OFF) / 4; u += NTHR) ((LAS unsigned*)(ldsl + LDSCTL_OFF))[u] = 0u;
    __syncthreads();
    LAS unsigned long long* const PT = (LAS unsigned long long*)(ldsl + PTAB_OFF);
    if (C0.tid == 0) {
#pragma unroll
        for (int i = 0; i < 25; ++i) PT[i] = (unsigned long long)args.in[i];
        PT[25] = (unsigned long long)args.out; PT[26] = (unsigned long long)args.ws; }
    __syncthreads();
#define PTR(i) ptab_get(PT, (i))
#define IN(i) ((const float*)(const GAS float*)PTR(i))
#define OUTP ((float*)(GAS float*)PTR(25))
#define WSP ((unsigned char*)(GAS unsigned char*)PTR(26))
    XcdBarrier bar; bar.pt = PT; bar.x = 0; bar.st = nullptr;
    if (!MK_LAUNCH_PER_STEP) bar = xcd_barrier_post(PT, MISC + 8);
    const int lo = args.step_lo, hi = args.step_hi;
    int step = 0;
#define PH_BEGIN if (step >= lo && step < hi) { Ctx C = C0; { int t_ = threadIdx.x; asm volatile("" : "+v"(t_)); C.tid = t_; C.lane = t_ & 63; C.wave = __builtin_amdgcn_readfirstlane(t_ >> 6); asm volatile("" : "+s"(C.G), "+s"(C.vcu)); C.NGW = C.G * NWAVES; C.gw = C.vcu * NWAVES + C.wave; } \
    LAS float* const cscr = (LAS float*)ldsl + C.wave * (64 * 65);
#define PH_END } { ++step; if (!MK_LAUNCH_PER_STEP && step > lo && step < hi) xcd_barrier(bar); }

#define XN ((bf16*)(WSP + WS_XN))
#define AO ((bf16*)(WSP + WS_AO))
#define WQKV ((bf16*)(WSP + WS_WB + WB_QKV))
#define WOUT ((bf16*)(WSP + WS_WB + WB_OUT))
#define W1T ((bf16*)(WSP + WS_WB + WB_W1))
#define W2T ((bf16*)(WSP + WS_WB + WB_W2))
#define BIG (WSP + WS_BIG)
#define H3 ((float*)(WSP + WS_H3))
#define LSE ((float*)(WSP + WS_LSE))
#define BIASP ((float*)(WSP + WS_BIASP))
#define SSA ((float*)(WSP + WS_SSA))
#define SSB ((float*)(WSP + WS_SSB))
#define out OUTP
#define ws WSP

    for (int layer = 0; layer < DEPTH; ++layer) {
        const int j = layer >> 1; const bool attn = (layer & 1) == 0;

        PH_BEGIN
          for (int rep_ = 0; rep_ < REP_N; ++rep_) {
            int ib = 0;
            if (attn) { convert_matrix<1>(C, cscr, IN(4) + (size_t)j * D * QKVW, D, QKVW, QKVW, WQKV, ib, IN(2) + (size_t)layer * D); convert_matrix<0>(C, cscr, IN(7) + (size_t)j * D * D, D, D, D, WOUT, ib, nullptr); }
            else { convert_matrix<2>(C, cscr, IN(8) + (size_t)j * D * 3 * D, D, 3 * D, 3 * D, WQKV, ib, IN(2) + (size_t)layer * D); convert_matrix<0>(C, cscr, IN(21) + (size_t)j * D * D, D, D, D, WOUT, ib, nullptr); }
            convert_matrix<0>(C, cscr, IN(23) + (size_t)layer * D * DFF, D, DFF, DFF, W1T, ib, IN(3) + (size_t)layer * D);
            convert_matrix<0>(C, cscr, IN(24) + (size_t)layer * DFF * D, DFF, D, D, W2T, ib, nullptr);
            if (layer == 0) ph_x0(C, IN(0), IN(1), XN, SSB);
            if (!attn) {
                for (int r3_ = 0; r3_ < REP_FH; ++r3_) ph_filter_hidden(C, IN(12) + (size_t)j * 33 * 64, IN(13) + j * 64, IN(14) + (size_t)j * 4096, IN(15) + j * 64, IN(16) + (size_t)j * 4096, IN(17) + j * 64, IN(18) + j * 64, H3);
                for (int n = C.gw * 64 + C.lane; n < 3 * D; n += C.NGW * 64) { const int n0 = n & ~31; BIASP[n] = IN(9)[(size_t)j * 3 * D + map_src_col<2>(n0) + (n & 31)]; }
            }
          }
        PH_END
        for (int chunk = 0; chunk < (attn ? NHC : NCH); ++chunk) {
            PH_BEGIN
              for (int rep_ = 0; rep_ < REP_G; ++rep_) {
                const int Nc = attn ? QCW : UCW;
                pg8::Gemm g{XN, WQKV + (size_t)chunk * Nc * D, M, Nc, D}; pg8::NormOrder S; S.init(M, Nc, C.G, (int)blockIdx.x); S.ss = SSB; S.tbl = ldsl + RING_BYTES;
                pg8::EpiBf16<0> E{(bf16*)(BIG + BIG_QKV), Nc, attn ? nullptr : BIASP + chunk * UCW, ldsl + RING_BYTES, attn ? HC : 0, IN(5) + (size_t)j * 3 * HD, IN(6) + (size_t)j * 3 * HD, (LAS float*)(ldsl + RING_BYTES + 20480), MP, LP - 1, LS - 1};
                pg8::gemm_phase<pg8::EpiBf16<0>, pg8::NormOrder, true, true>(ldsl, g, S, E);
              }
            PH_END
            if (!attn) {
            PH_BEGIN
                { Ctx Ch = C; bool do_gate = true, do_fgen = true;
                  if (MK_P2_SPLIT && (C.G & 1) == 0) { Ch.G = C.G >> 1; Ch.vcu = C.vcu >> 1; Ch.gw = Ch.vcu * NWAVES + C.wave; Ch.NGW = Ch.G * NWAVES; do_gate = (C.vcu & 1) == 0; do_fgen = !do_gate; }
                  if (do_gate) ph_gate(Ch, lds, (const bf16*)(BIG + BIG_U), IN(10) + (size_t)j * 9 * D, IN(11) + (size_t)j * 3 * D, (unsigned*)(BIG + BIG_ZC), (unsigned*)(BIG + BIG_X0C), chunk);
                  if (do_fgen) ph_filter_gen(Ch, lds, H3, IN(19) + (size_t)j * 64 * 2 * D, (unsigned*)(BIG + BIG_HT), chunk); }
            PH_END
            }
            PH_BEGIN
                if (attn) for (int rep_ = 0; rep_ < REP_A; ++rep_) ph_attn(C, (const bf16*)(BIG + BIG_QKV), (bf16*)(BIG + BIG_OG), LSE, lds);
                else for (int rep_ = 0; rep_ < REP_F; ++rep_) ph_fft(C, lds, (const unsigned*)(BIG + BIG_HT), (const unsigned*)(BIG + BIG_ZC), (const unsigned*)(BIG + BIG_X0C), (unsigned*)(BIG + BIG_YC), IN(20) + (size_t)j * D, (unsigned*)(ws + WS_FSCR), chunk);
            PH_END
            PH_BEGIN
              for (int rep_ = 0; rep_ < REP_4; ++rep_) {
                if (attn) ph_combine(C, (const bf16*)(BIG + BIG_OG), LSE, AO, chunk);
                else ph_ytrans(C, lds, (const unsigned*)(BIG + BIG_YC), (const bf16*)(BIG + BIG_U), IN(10) + (size_t)j * 9 * D, IN(11) + (size_t)j * 3 * D, AO, chunk);
              }
            PH_END
        }
        PH_BEGIN
          for (int rep_ = REP_R - 1; rep_ >= 0; --rep_) {
            pg8::Gemm g{AO, WOUT, M, D, D}; pg8::StaticOrder S; S.init(M, D, C.G, (int)blockIdx.x);
            pg8::EpiResF32 E{rep_ ? (float*)(BIG) : out, D, attn ? nullptr : IN(22) + (size_t)j * D, rep_ ? (bf16*)(BIG + 352 * MiB) : XN, rep_ ? (float*)(BIG + 520 * MiB) : SSA, (LAS float*)(ldsl + RING_BYTES + 16384), layer == 0 ? IN(0) : (const float*)out, layer == 0 ? IN(1) : (const float*)(out + (size_t)MP * D), MP};
            pg8::gemm_phase<pg8::EpiResF32, pg8::StaticOrder, true, true>(ldsl, g, S, E);
          }
        PH_END
        for (int tc = 0; tc <= NMLPC; ++tc) {
            PH_BEGIN
                if (tc >= 1) {
                    const int pc = tc - 1;
                  for (int rep_ = REP_R - 1; rep_ >= 0; --rep_) {
                    pg8::Gemm g{(const bf16*)(BIG + BIG_H + (size_t)(pc & 1) * H_BYTES), W2T, MLPC, D, DFF}; pg8::StaticOrder S; S.init(MLPC, D, C.G, (int)blockIdx.x);
                    pg8::EpiResF32 E{rep_ ? (float*)(BIG + 256 * MiB) : out + (size_t)pc * MLPC * D, D, nullptr, rep_ ? (bf16*)(BIG + 320 * MiB) : XN + (size_t)pc * MLPC * D, rep_ ? (float*)(BIG + 352 * MiB) : SSB + (size_t)pc * MLPC * 8, (LAS float*)(ldsl + RING_BYTES + 16384), out + (size_t)pc * MLPC * D, out + (size_t)pc * MLPC * D, 0};
                    pg8::gemm_phase<pg8::EpiResF32, pg8::StaticOrder, true, true>(ldsl, g, S, E);
                  }
                }
                if (tc < NMLPC) {
                  for (int rep_ = 0; rep_ < REP_G; ++rep_) {
                    pg8::Gemm g{XN + (size_t)tc * MLPC * D, W1T, MLPC, DFF, D}; pg8::NormOrder S; S.init(MLPC, DFF, C.G, (int)blockIdx.x); S.ss = SSA + (size_t)tc * MLPC * 8; S.tbl = ldsl + RING_BYTES;
                    pg8::EpiBf16<3> E{(bf16*)(BIG + BIG_H + (size_t)(tc & 1) * H_BYTES), DFF, nullptr, ldsl + RING_BYTES, 0, nullptr, nullptr, nullptr, 0, 0, 0};
                    pg8::gemm_phase<pg8::EpiBf16<3>, pg8::NormOrder, true, true>(ldsl, g, S, E);
                  }
                }
            PH_END
        }
#if XB_EXTRA
#pragma unroll 1
        for (int e_ = 0; e_ < XB_EXTRA; ++e_) xcd_barrier(bar);
#endif
    }
#undef out
#undef ws
#undef PH_BEGIN
#undef PH_END
}

extern "C" void kernel_launch(void* const* d_in, const int* in_sizes, int n_in, void* d_out, int out_size, void* d_ws, size_t ws_size, hipStream_t stream) {
    static int grid = 0;
    if (grid == 0) {
        if (n_in != 25 || out_size != M * D || ws_size < WS_END) { fprintf(stderr, "kernel_launch: unexpected problem (n_in %d, out %d, ws %zu < %zu)\n", n_in, out_size, ws_size, (size_t)WS_END); grid = -1; return; }
        int dev = 0, cus = 0, per_cu = 0;
        if (hipGetDevice(&dev) != hipSuccess || hipDeviceGetAttribute(&cus, hipDeviceAttributeMultiprocessorCount, dev) != hipSuccess) { grid = -1; return; }
        if (hipFuncSetAttribute((const void*)mega_fwd, hipFuncAttributeMaxDynamicSharedMemorySize, LDS_BYTES) != hipSuccess) { fprintf(stderr, "kernel_launch: hipFuncSetAttribute failed\n"); grid = -1; return; }
        if (hipOccupancyMaxActiveBlocksPerMultiprocessor(&per_cu, (const void*)mega_fwd, NTHR, LDS_BYTES) != hipSuccess || per_cu < 1) fprintf(stderr, "kernel_launch: occupancy query reports %d\n", per_cu);
        (void)hipGetLastError();
        grid = cus > 256 ? 256 : cus;
    }
    if (grid < 0) return;
    if (hipMemsetAsync((char*)d_ws + WS_CTL, 0, CTL_ZERO_BYTES, stream) != hipSuccess) return;
    Args a{};
    for (int i = 0; i < 25; ++i) a.in[i] = (const float*)d_in[i];
    a.out = (float*)d_out; a.ws = (unsigned char*)d_ws;
#if MK_LAUNCH_PER_STEP
    for (int s = 0; s < NSTEPS; ++s) { a.step_lo = s; a.step_hi = s + 1; hipLaunchKernelGGL(mega_fwd, dim3(grid), dim3(NTHR), LDS_BYTES, stream, a); }
#else
    a.step_lo = 0; a.step_hi = NSTEPS;
    hipLaunchKernelGGL(mega_fwd, dim3(grid), dim3(NTHR), LDS_BYTES, stream, a);
#endif
    const hipError_t le = hipPeekAtLastError();
    if (le != hipSuccess) fprintf(stderr, "kernel_launch: launch failed: %s\n", hipGetErrorName(le));
}
```

```cpp
#include <hip/hip_runtime.h>
#include <cstdio>
#include <cstdint>
#include <cmath>
namespace pg8 {
#define PG8_LAS __attribute__((address_space(3)))
typedef unsigned short bf16_t;
typedef short bf16x8 __attribute__((ext_vector_type(8)));
typedef float f32x4 __attribute__((ext_vector_type(4)));
typedef unsigned u32x4 __attribute__((ext_vector_type(4)));
constexpr int BM = 256, BK = 64, HALF = 128, HTB = HALF * BK * 2  , STAGE_BYTES = 8 * HTB, NXCD = 8, WGM = 4;

__host__ __device__ __forceinline__ int lds_byte(int r, int c) { const int st = (r >> 4) * 2 + (c >> 5), rr = r & 15, cc = c & 31, ob = rr * 64 + cc * 2; return st * 1024 + (ob ^ (((ob >> 9) & 1) << 5)); }
__host__ __device__ __forceinline__ void stage_rc(int b, int& R, int& C) { const int st = b / 1024, sb = b % 1024, swz = sb ^ (((sb >> 9) & 1) << 5); R = (st >> 1) * 16 + swz / 64; C = (st & 1) * 32 + (swz % 64) / 2; }
__host__ __device__ __forceinline__ int perm32(int rho) { const int n = rho >> 4, i = rho & 15; return 8 * (i >> 2) + 4 * n + (i & 3); }

struct Unit { int pm, pn; };
struct Gemm { const bf16_t* A; const bf16_t* Bt; int M, N, K; };

struct StaticOrder {
    int nM, nN, nwg, G, c;
    __host__ __device__ void init(int M, int N, int G_, int c_) { nM = M / BM; nN = N / BM; nwg = nM * nN; G = G_; c = c_; }
    __host__ __device__ bool next(int i, Unit& u) const {
        const long L = (long)i * G + c; if (L >= nwg) return false;
        int wgid = (int)L; { const int q = nwg / NXCD, r = nwg % NXCD, xcd = wgid % NXCD, off = wgid / NXCD; wgid = (xcd < r ? xcd * (q + 1) : r * (q + 1) + (xcd - r) * q) + off; }
        const int nig = WGM * nN, gid = wgid / nig, fm = gid * WGM, gsz = (nM - fm) < WGM ? (nM - fm) : WGM;
        u.pm = fm + ((wgid % nig) % gsz); u.pn = (wgid % nig) / gsz; return true;
    }
    __device__ __forceinline__ void a_ready(const Unit&, int, int, int) const {}
    __device__ __forceinline__ void done(const Unit&) const {}
};

struct NormOrder : StaticOrder {
    const float* ss; PG8_LAS unsigned char* tbl;
    __device__ __forceinline__ void a_ready(const Unit& u, int ui, int wid, int lane) const {
        __builtin_amdgcn_global_load_lds((const unsigned*)(ss + ((size_t)u.pm * BM + wid * 32) * 8 + lane * 4), (PG8_LAS unsigned*)(tbl + (ui & 1) * 8192 + wid * 1024), 16, 0, 0);
    }
};
__device__ __forceinline__ unsigned cvt_pk_bf16(float lo, float hi) { unsigned r; asm volatile("v_cvt_pk_bf16_f32 %0, %1, %2" : "=v"(r) : "v"(lo), "v"(hi)); return r; }
typedef float f32x2 __attribute__((ext_vector_type(2)));
__device__ __forceinline__ f32x2 gelu_pk(f32x2 v) {
    const f32x2 av = __builtin_elementwise_abs(v), d = av * 0.2316418882f + 1.0f;
    f32x2 t; t.x = __builtin_amdgcn_rcpf(d.x); t.y = __builtin_amdgcn_rcpf(d.y);
    f32x2 q = t * 0.5307027145f + (-0.7265760135f); q = q * t + 0.7107068705f; q = q * t + (-0.142248368f); q = q * t + 0.127414796f; q = q * t;
    const f32x2 s = (v * v) * (-0.72134752044f);
    f32x2 e; e.x = __builtin_amdgcn_exp2f(s.x); e.y = __builtin_amdgcn_exp2f(s.y);
    const f32x2 m = v * (q * e), r = v - m;
    f32x2 o; o.x = v.x < 0.f ? m.x : r.x; o.y = v.y < 0.f ? m.y : r.y; return o;
}


template <int ACT  > struct EpiBf16 {
    static constexpr bool PERM = true, AFTER_DRAIN = false;
    bf16_t* O; int ldc; const float* bias; const PG8_LAS unsigned char* tbl; int qk_hc; const float* qg; const float* kg; PG8_LAS float* xq; int mp, lpm, lsm;
    __device__ __forceinline__ void operator()(const f32x4 (&acc)[2][2][4][2], const Unit& u, int ui, int wr, int wc, int fr, int fq) const {
        const int row0 = u.pm * BM + wr * 64 + fr; const int col0 = u.pn * BM + wc * 32 + 8 * fq;
        f32x4 bv[2][2];
#pragma unroll
        for (int bj = 0; bj < 2; ++bj)
#pragma unroll
            for (int n = 0; n < 2; ++n) bv[bj][n] = bias ? *(const f32x4*)(bias + col0 + bj * HALF + 4 * n) : (f32x4){0.f, 0.f, 0.f, 0.f};
        float rs[2][4];
#pragma unroll
        for (int ai = 0; ai < 2; ++ai)
#pragma unroll
            for (int m = 0; m < 4; ++m) { float tot = 2048.0f; if (tbl) { const PG8_LAS f32x4* tp = (const PG8_LAS f32x4*)(tbl + (ui & 1) * 8192 + (ai * HALF + wr * 64 + m * 16 + fr) * 32); const f32x4 p0 = tp[0], p1 = tp[1]; tot = ((p0[0] + p0[1]) + (p0[2] + p0[3])) + ((p1[0] + p1[1]) + (p1[2] + p1[3])); }
                rs[ai][m] = tbl ? 1.0f / sqrtf(tot * (1.0f / 2048.0f) + 1e-6f) : 1.0f; }
        int kind = 2, grp = 0;
        if (qk_hc > 0) { const int gt = (2 * u.pn) / qk_hc; kind = gt % 3; grp = gt / 3; }
        const bool qk = kind != 2;
        const int lane = fq * 16 + fr;
        f32x4 glo = {1.f, 1.f, 1.f, 1.f}, ghi = glo; float inv[4] = {0.f, 0.f, 0.f, 0.f};
        if (qk) {
#pragma unroll
            for (int ai = 0; ai < 2; ++ai)
#pragma unroll
                for (int m = 0; m < 4; ++m)
#pragma unroll
                    for (int bj = 0; bj < 2; ++bj) { const f32x4 a = acc[ai][bj][m][0] * rs[ai][m], b = acc[ai][bj][m][1] * rs[ai][m];
                        float sq = ((a[0] * a[0] + a[1] * a[1]) + (a[2] * a[2] + a[3] * a[3])) + ((b[0] * b[0] + b[1] * b[1]) + (b[2] * b[2] + b[3] * b[3]));
                        sq += __builtin_bit_cast(float, __builtin_amdgcn_ds_bpermute((lane ^ 16) << 2, __builtin_bit_cast(int, sq)));
                        sq += __builtin_bit_cast(float, __builtin_amdgcn_ds_bpermute((lane ^ 32) << 2, __builtin_bit_cast(int, sq)));
                        if (fq == 0) xq[((ai * HALF + wr * 64 + m * 16 + fr) * 2 + bj) * 4 + wc] = sq; }
            const float* gp = (kind == 0 ? qg : kg) + grp * 128 + 16 * wc + 4 * fq;
            glo = *(const f32x4*)gp; ghi = *(const f32x4*)(gp + 64);
#pragma unroll
            for (int e = 0; e < 4; ++e) inv[e] = __builtin_amdgcn_exp2f(-(float)(16 * wc + 4 * fq + e) * (13.287712379549449f / 64.0f));
            asm volatile("s_waitcnt lgkmcnt(0)" ::: "memory"); __builtin_amdgcn_s_barrier(); asm volatile("" ::: "memory");
        }
        const float qsc = kind == 0 ? 0.08838834764831845f * 1.4426950408889634f : 1.0f;
#pragma unroll
        for (int ai = 0; ai < 2; ++ai)
#pragma unroll
            for (int m = 0; m < 4; ++m) { const int row = row0 + ai * HALF + m * 16; bf16_t* rowp = O + (size_t)row * ldc + col0; const float sc = rs[ai][m];
                float cs[4] = {1.f, 1.f, 1.f, 1.f}, sn[4] = {0.f, 0.f, 0.f, 0.f};
                if (qk) { const float pos = (float)(row < mp ? (row & lpm) : ((row - mp) & lsm));
#pragma unroll
                    for (int e = 0; e < 4; ++e) { float rev = pos * inv[e] * 0.15915494309189535f; rev -= __builtin_floorf(rev); cs[e] = __builtin_amdgcn_cosf(rev); sn[e] = __builtin_amdgcn_sinf(rev); } }
#pragma unroll
                for (int bj = 0; bj < 2; ++bj) { f32x4 v0 = acc[ai][bj][m][0] * sc + bv[bj][0], v1 = acc[ai][bj][m][1] * sc + bv[bj][1];
                    if (ACT == 3) {
#pragma unroll
                        for (int j = 0; j < 4; ++j) { const float a = fmaxf(v0[j], 0.f), b = fmaxf(v1[j], 0.f); v0[j] = a * a; v1[j] = b * b; } }
                    if (qk) { const f32x4 pt = *(const PG8_LAS f32x4*)(xq + ((ai * HALF + wr * 64 + m * 16 + fr) * 2 + bj) * 4);
                        const float r = qsc / sqrtf(((pt[0] + pt[1]) + (pt[2] + pt[3])) * (1.0f / 128.0f) + 1e-6f);
#pragma unroll
                        for (int e = 0; e < 4; ++e) { const float y0 = v0[e] * r * glo[e], y1 = v1[e] * r * ghi[e]; v0[e] = y0 * cs[e] - y1 * sn[e]; v1[e] = y1 * cs[e] + y0 * sn[e]; } }
                    u32x4 w; w.x = cvt_pk_bf16(v0[0], v0[1]); w.y = cvt_pk_bf16(v0[2], v0[3]); w.z = cvt_pk_bf16(v1[0], v1[1]); w.w = cvt_pk_bf16(v1[2], v1[3]);
                    *(u32x4*)(rowp + bj * HALF) = w; } }
    }
};
struct EpiResF32 {
    static constexpr bool PERM = true, AFTER_DRAIN = false;
    float* C; int ldc; const float* bias; bf16_t* XB; float* SS; PG8_LAS float* xl;
    const float* Cin0; const float* Cin1; int msplit;
    __device__ __forceinline__ void operator()(const f32x4 (&acc)[2][2][4][2], const Unit& u, int  , int wr, int wc, int fr_, int fq_) const {
        int fr = fr_, fq = fq_; asm volatile("" : "+v"(fr), "+v"(fq));
        const int row0 = u.pm * BM + wr * 64 + fr, col0 = u.pn * BM + wc * 32 + 8 * fq;
        f32x4 bv[2][2];
#pragma unroll
        for (int bj = 0; bj < 2; ++bj)
#pragma unroll
            for (int n = 0; n < 2; ++n) bv[bj][n] = bias ? *(const f32x4*)(bias + col0 + bj * HALF + n * 4) : (f32x4){0.f, 0.f, 0.f, 0.f};
        const int lane = fq * 16 + fr;
#pragma unroll
        for (int ai = 0; ai < 2; ++ai) {
            f32x4 r[4][2][2];
#pragma unroll
            for (int m = 0; m < 4; ++m) { const int rr_ = row0 + ai * HALF + m * 16; const float* rowp = (rr_ < msplit ? Cin0 + (size_t)rr_ * ldc : Cin1 + (size_t)(rr_ - msplit) * ldc) + col0;
#pragma unroll
                for (int bj = 0; bj < 2; ++bj)
#pragma unroll
                    for (int n = 0; n < 2; ++n) r[m][bj][n] = *(const f32x4*)(rowp + bj * HALF + n * 4); }
#pragma unroll
            for (int m = 0; m < 4; ++m) { const int row = row0 + ai * HALF + m * 16; float* rowp = C + (size_t)row * ldc + col0; bf16_t* xbp = XB + (size_t)row * ldc + col0;
                float sq = 0.f;
#pragma unroll
                for (int bj = 0; bj < 2; ++bj) { const f32x4 v0 = r[m][bj][0] + acc[ai][bj][m][0] + bv[bj][0], v1 = r[m][bj][1] + acc[ai][bj][m][1] + bv[bj][1];
                    *(f32x4*)(rowp + bj * HALF) = v0; *(f32x4*)(rowp + bj * HALF + 4) = v1;
                    u32x4 w; w.x = cvt_pk_bf16(v0[0], v0[1]); w.y = cvt_pk_bf16(v0[2], v0[3]); w.z = cvt_pk_bf16(v1[0], v1[1]); w.w = cvt_pk_bf16(v1[2], v1[3]); *(u32x4*)(xbp + bj * HALF) = w;
                    sq += ((v0[0] * v0[0] + v0[1] * v0[1]) + (v0[2] * v0[2] + v0[3] * v0[3])) + ((v1[0] * v1[0] + v1[1] * v1[1]) + (v1[2] * v1[2] + v1[3] * v1[3])); }
                sq += __builtin_bit_cast(float, __builtin_amdgcn_ds_bpermute((lane ^ 16) << 2, __builtin_bit_cast(int, sq)));
                sq += __builtin_bit_cast(float, __builtin_amdgcn_ds_bpermute((lane ^ 32) << 2, __builtin_bit_cast(int, sq)));
                if (fq == 0) xl[(ai * HALF + wr * 64 + m * 16 + fr) * 4 + wc] = sq; }
            asm volatile("" ::: "memory"); }
        asm volatile("s_waitcnt lgkmcnt(0)" ::: "memory"); __builtin_amdgcn_s_barrier(); asm volatile("" ::: "memory");
        { int t = (wr * 4 + wc) * 64 + lane; asm volatile("" : "+v"(t));
          if (t < BM) { const f32x4 q = *(const PG8_LAS f32x4*)(xl + t * 4); SS[(size_t)(u.pm * BM + t) * 8 + u.pn] = (q[0] + q[1]) + (q[2] + q[3]); } }
        asm volatile("s_waitcnt lgkmcnt(0)" ::: "memory"); __builtin_amdgcn_s_barrier(); asm volatile("" ::: "memory");
    }
};

template <class Epi, class Sched, bool ALIGN_EPI = false, bool SP2 = false>
__device__ __forceinline__ void gemm_phase(PG8_LAS unsigned char* lds, const Gemm g, const Sched& S, const Epi& E) {
    int tid_o = threadIdx.x; asm volatile("" : "+v"(tid_o));
    const int tid = tid_o, wid = __builtin_amdgcn_readfirstlane(tid >> 6), lane = tid & 63, wr = wid >> 2, wc = wid & 3, fr = lane & 15, fq = lane >> 4;
    const int K = g.K, nt = K / BK;
    unsigned voffA[2], voffB[2];
#pragma unroll
    for (int i = 0; i < 2; ++i) { int R, C; stage_rc(tid * 16 + i * 8192, R, C); const int Rb = Epi::PERM ? ((R & ~31) + perm32(R & 31)) : R;
        voffA[i] = (unsigned)(R * K + C) * 2u; voffB[i] = (unsigned)(Rb * K + C) * 2u; }
    const size_t kstep = (size_t)(BK * 2);
    const size_t hstep = (size_t)HALF * K * 2;
    const size_t tstep = 2 * hstep;
    const unsigned ldsw = (unsigned)wid * 1024u;
    const int aoff = lds_byte(wr * 64 + fr, fq * 8), boff = lds_byte(wc * 32 + fr, fq * 8);
#define PG8_SA(b, h) (((b) * 2 + (h)) * HTB)
#define PG8_SB(b, h) ((4 + (b) * 2 + (h)) * HTB)
#define PG8_STAGE(bufoff, gbase, voff) do { _Pragma("unroll") for (int _i = 0; _i < 2; ++_i) \
        __builtin_amdgcn_global_load_lds((const unsigned*)((const char*)(gbase) + (voff)[_i]), (PG8_LAS unsigned*)(lds + (bufoff) + ldsw + _i * 8192), 16, 0, 0); } while (0)
#define PG8_LDA(dst, b, h) do { _Pragma("unroll") for (int m = 0; m < 4; ++m) _Pragma("unroll") for (int k = 0; k < 2; ++k) dst[m][k] = *(const PG8_LAS bf16x8*)(lds + PG8_SA(b, h) + aoff + m * 2048 + k * 1024); } while (0)
#define PG8_LDB(dst, b, h) do { _Pragma("unroll") for (int n = 0; n < 2; ++n) _Pragma("unroll") for (int k = 0; k < 2; ++k) dst[n][k] = *(const PG8_LAS bf16x8*)(lds + PG8_SB(b, h) + boff + n * 2048 + k * 1024); } while (0)
#define PG8_MMA(ai, bj, At, Bt) do { __builtin_amdgcn_s_setprio(1); _Pragma("unroll") for (int m = 0; m < 4; ++m) _Pragma("unroll") for (int n = 0; n < 2; ++n) _Pragma("unroll") for (int k = 0; k < 2; ++k) \
        acc[ai][bj][m][n] = __builtin_amdgcn_mfma_f32_16x16x32_bf16(Bt[n][k], At[m][k], acc[ai][bj][m][n], 0, 0, 0); __builtin_amdgcn_s_setprio(0); } while (0)
#define PG8_WAIT_V(n) asm volatile("s_waitcnt vmcnt(" #n ")" ::: "memory")
#define PG8_WAIT_L(n) asm volatile("s_waitcnt lgkmcnt(" #n ")" ::: "memory")
#define PG8_BAR __builtin_amdgcn_s_barrier()
#define PG8_SCHED __builtin_amdgcn_sched_barrier(0)
    Unit cur, nxt; int ui = 0;
    if (!S.next(0, cur)) return;
    f32x4 acc[2][2][4][2];
#pragma unroll
    for (int a = 0; a < 2; ++a)
#pragma unroll
        for (int b = 0; b < 2; ++b)
#pragma unroll
            for (int m = 0; m < 4; ++m)
#pragma unroll
                for (int n = 0; n < 2; ++n) acc[a][b][m][n] = (f32x4){0.f, 0.f, 0.f, 0.f};
    bf16x8 At[4][2], B0[2][2], B1[2][2];
    const char* cA = (const char*)g.A + (size_t)cur.pm * tstep; const char* cB = (const char*)g.Bt + (size_t)cur.pn * tstep;
    S.a_ready(cur, 0, wid, lane);
    if constexpr (SP2) {
        PG8_STAGE(PG8_SB(0, 0), cB, voffB); PG8_STAGE(PG8_SB(0, 1), cB + hstep, voffB); PG8_STAGE(PG8_SA(0, 0), cA, voffA); PG8_STAGE(PG8_SA(0, 1), cA + hstep, voffA);
        if (wr == 1) PG8_BAR;
        PG8_WAIT_V(2); PG8_BAR;
        PG8_STAGE(PG8_SB(1, 0), cB + kstep, voffB); PG8_STAGE(PG8_SA(1, 0), cA + kstep, voffA); PG8_STAGE(PG8_SB(1, 1), cB + hstep + kstep, voffB);
        PG8_WAIT_V(6); PG8_BAR;
    } else {
        PG8_STAGE(PG8_SB(0, 0), cB, voffB); PG8_STAGE(PG8_SA(0, 0), cA, voffA); PG8_STAGE(PG8_SB(0, 1), cB + hstep, voffB); PG8_STAGE(PG8_SA(0, 1), cA + hstep, voffA);
        if (wr == 1) PG8_BAR;
        PG8_WAIT_V(4); PG8_BAR;
        PG8_STAGE(PG8_SB(1, 0), cB + kstep, voffB); PG8_STAGE(PG8_SA(1, 0), cA + kstep, voffA); PG8_STAGE(PG8_SB(1, 1), cB + hstep + kstep, voffB);
        PG8_WAIT_V(6); PG8_BAR;
    }
    for (;;) {
        const bool has_next = S.next(ui + 1, nxt);
        const char* nA = has_next ? (const char*)g.A + (size_t)nxt.pm * tstep : cA; const char* nB = has_next ? (const char*)g.Bt + (size_t)nxt.pn * tstep : cB;
        for (int t = 0; t < nt; t += 2) {
            const bool last = (t == nt - 2);
            const char* a1 = cA + (size_t)(t + 1) * kstep;
            const char* a2 = last ? nA : cA + (size_t)(t + 2) * kstep; const char* b2 = last ? nB : cB + (size_t)(t + 2) * kstep;
            const char* a3 = a2 + kstep; const char* b3 = b2 + kstep;
            if (last && has_next) S.a_ready(nxt, ui + 1, wid, lane);
            if constexpr (SP2) {
            PG8_LDB(B0, 0, 0); PG8_LDB(B1, 0, 1); PG8_SCHED; PG8_LDA(At, 0, 0); PG8_STAGE(PG8_SA(1, 1), a1 + hstep, voffA);
            PG8_WAIT_V(8); PG8_WAIT_L(0); PG8_BAR; PG8_MMA(0, 0, At, B0); PG8_MMA(0, 1, At, B1); PG8_BAR; PG8_SCHED;
            PG8_LDA(At, 0, 1); PG8_STAGE(PG8_SB(0, 0), b2, voffB); PG8_STAGE(PG8_SB(0, 1), b2 + hstep, voffB); PG8_STAGE(PG8_SA(0, 0), a2, voffA);
            PG8_WAIT_V(8); PG8_WAIT_L(0); PG8_BAR; PG8_MMA(1, 0, At, B0); PG8_MMA(1, 1, At, B1); PG8_BAR; PG8_SCHED;
            PG8_LDB(B0, 1, 0); PG8_LDB(B1, 1, 1); PG8_SCHED; PG8_LDA(At, 1, 0); PG8_STAGE(PG8_SA(0, 1), a2 + hstep, voffA);
            PG8_WAIT_V(8); PG8_WAIT_L(0); PG8_BAR; PG8_MMA(0, 0, At, B0); PG8_MMA(0, 1, At, B1); PG8_BAR; PG8_SCHED;
            PG8_LDA(At, 1, 1); PG8_STAGE(PG8_SB(1, 0), b3, voffB); PG8_STAGE(PG8_SB(1, 1), b3 + hstep, voffB); PG8_STAGE(PG8_SA(1, 0), a3, voffA);
            PG8_WAIT_V(8); PG8_WAIT_L(0); PG8_BAR; PG8_MMA(1, 0, At, B0); PG8_MMA(1, 1, At, B1); PG8_BAR; PG8_SCHED;
            } else {
            PG8_LDB(B0, 0, 0); PG8_SCHED; PG8_LDA(At, 0, 0); PG8_STAGE(PG8_SA(1, 1), a1 + hstep, voffA);
            PG8_WAIT_L(8); PG8_BAR; PG8_WAIT_L(0); PG8_MMA(0, 0, At, B0); PG8_BAR; PG8_SCHED;
            PG8_LDB(B1, 0, 1); PG8_STAGE(PG8_SB(0, 0), b2, voffB);
            PG8_BAR; PG8_WAIT_L(0); PG8_MMA(0, 1, At, B1); PG8_BAR;
            PG8_LDA(At, 0, 1); PG8_STAGE(PG8_SA(0, 0), a2, voffA);
            PG8_BAR; PG8_WAIT_L(0); PG8_MMA(1, 0, At, B0); PG8_BAR; PG8_SCHED;
            PG8_STAGE(PG8_SB(0, 1), b2 + hstep, voffB);
            PG8_WAIT_V(6); PG8_BAR; PG8_MMA(1, 1, At, B1); PG8_BAR;
            PG8_LDB(B0, 1, 0); PG8_SCHED; PG8_LDA(At, 1, 0); PG8_STAGE(PG8_SA(0, 1), a2 + hstep, voffA);
            PG8_WAIT_L(8); PG8_BAR; PG8_WAIT_L(0); PG8_MMA(0, 0, At, B0); PG8_BAR; PG8_SCHED;
            PG8_LDB(B1, 1, 1); PG8_STAGE(PG8_SB(1, 0), b3, voffB);
            PG8_BAR; PG8_WAIT_L(0); PG8_MMA(0, 1, At, B1); PG8_BAR;
            PG8_LDA(At, 1, 1); PG8_STAGE(PG8_SA(1, 0), a3, voffA);
            PG8_BAR; PG8_WAIT_L(0); PG8_MMA(1, 0, At, B0); PG8_BAR; PG8_SCHED;
            PG8_STAGE(PG8_SB(1, 1), b3 + hstep, voffB);
            PG8_WAIT_V(6); PG8_BAR; PG8_MMA(1, 1, At, B1); PG8_BAR;
            }
        }
        if constexpr (ALIGN_EPI) { if (wr == 0) PG8_BAR; }
        if constexpr (!Epi::AFTER_DRAIN) { E(acc, cur, ui, wr, wc, fr, fq); S.done(cur); }
        if (!has_next) break;
#pragma unroll
        for (int a = 0; a < 2; ++a)
#pragma unroll
            for (int b = 0; b < 2; ++b)
#pragma unroll
                for (int m = 0; m < 4; ++m)
#pragma unroll
                    for (int n = 0; n < 2; ++n) acc[a][b][m][n] = (f32x4){0.f, 0.f, 0.f, 0.f};
        cur = nxt; cA = nA; cB = nB; ++ui;
        if constexpr (ALIGN_EPI) { if (wr == 1) PG8_BAR; }
    }
    PG8_WAIT_V(0);
    if constexpr (!ALIGN_EPI) { if (wr == 0) PG8_BAR; }
    PG8_BAR;
    if constexpr (Epi::AFTER_DRAIN) { E.fused(acc, cur, wr, wc, fr, fq, lds, wid, lane); S.done(cur); }
#undef PG8_SA
#undef PG8_SB
#undef PG8_STAGE
#undef PG8_LDA
#undef PG8_LDB
#undef PG8_MMA
#undef PG8_WAIT_V
#undef PG8_WAIT_L
#undef PG8_BAR
#undef PG8_SCHED
}
}

constexpr int D = 2048, MP = 8192, MS = 32768, M = MP + MS, DFF = 8192, DEPTH = 4;
constexpr int LP = 2048, LS = 16384;
constexpr int QKVW = 18432, HD = 128;
#ifndef MK_HC
#define MK_HC 8
#endif
constexpr int HC = MK_HC, NHC = 16 / HC, QCW = 9 * HD * HC;
#ifndef MK_NCH
#define MK_NCH 2
#endif
constexpr int NCH = MK_NCH, CCH = D / NCH, UCW = 3 * CCH;
constexpr int MLPC = 8192, NMLPC = M / MLPC;
constexpr int NPOS = LP + LS;
constexpr int PPOS = 2 * LP + LS;
constexpr int NWAVES = 8, NTHR = 512;
constexpr float RMS_EPS = 1e-6f;

constexpr size_t MiB = 1u << 20;
constexpr size_t WS_CTL = 0, CTL_ZERO_BYTES = 1 * MiB;
constexpr size_t WS_H3 = 1 * MiB;
constexpr size_t WS_LSE = 7 * MiB;
constexpr size_t WS_BIASP = 6 * MiB;
constexpr size_t WS_SSA = 75 * MiB, WS_SSB = 77 * MiB;
constexpr size_t WS_FSCR = 11 * MiB;
constexpr size_t WS_WB = 79 * MiB;
constexpr size_t WB_QKV = 0, WB_OUT = 72 * MiB, WB_W1 = 80 * MiB, WB_W2 = 112 * MiB;
constexpr size_t WS_XN = 223 * MiB;
constexpr size_t WS_AO = 383 * MiB;
constexpr size_t WS_BIG = 543 * MiB;
constexpr size_t BIG_QKV = 0;
#ifndef MK_OG_INPLACE
#define MK_OG_INPLACE 1
#endif
constexpr size_t BIG_OG = MK_OG_INPLACE ? 0 : (size_t)M * QCW * 2;
constexpr size_t QKV_BYTES = (size_t)M * QCW * 2 + (MK_OG_INPLACE ? 0 : (size_t)3 * M * HC * HD * 2);
constexpr size_t BIG_U = 0;
constexpr size_t BIG_HT = BIG_U + (size_t)M * UCW * 2;
constexpr size_t BIG_ZC = BIG_HT + (size_t)CCH * 2 * NPOS * 4;
constexpr size_t BIG_X0C = BIG_ZC + (size_t)CCH * PPOS * 4;
constexpr size_t BIG_YC = BIG_X0C + (size_t)CCH * PPOS * 4;
constexpr size_t HY_BYTES = BIG_YC + (size_t)CCH * PPOS * 4;
constexpr size_t BIG_H = 0, H_BYTES = (size_t)MLPC * DFF * 2;
constexpr size_t BIG_BYTES = QKV_BYTES > HY_BYTES ? (QKV_BYTES > 2 * H_BYTES ? QKV_BYTES : 2 * H_BYTES) : (HY_BYTES > 2 * H_BYTES ? HY_BYTES : 2 * H_BYTES);
constexpr size_t WS_END = WS_BIG + BIG_BYTES;
static_assert((size_t)3 * M * HC * 4 <= 4 * MiB && WS_FSCR + 64 * MiB <= WS_SSA && (size_t)M * 8 * 4 <= 2 * MiB && WS_SSB + 2 * MiB <= WS_WB && WS_WB + 144 * MiB <= WS_XN && WS_XN + 160 * MiB <= WS_AO && WS_AO + 160 * MiB <= WS_BIG && BIG_HT % 256 == 0 && BIG_ZC % 256 == 0, "d_ws map");
constexpr int CW_BAR = 4096;

constexpr int RING_BYTES = 131072;
constexpr int SCRATCH_BYTES = 159744;
constexpr int LDSCTL_OFF = SCRATCH_BYTES, MISC_OFF = LDSCTL_OFF + 320, PTAB_OFF = LDSCTL_OFF + 512;
constexpr int LDS_BYTES = 160 * 1024;

#define GAS __attribute__((address_space(1)))
#define LAS __attribute__((address_space(3)))
#define DI __device__ __forceinline__
typedef unsigned short bf16;
typedef unsigned v4u __attribute__((ext_vector_type(4)));
typedef unsigned v2u __attribute__((ext_vector_type(2)));
typedef float f32x4 __attribute__((ext_vector_type(4)));
typedef float f32x2 __attribute__((ext_vector_type(2)));
typedef float f32x16 __attribute__((ext_vector_type(16)));
typedef short bf16x8 __attribute__((ext_vector_type(8)));
typedef short s16x4 __attribute__((ext_vector_type(4)));
typedef __bf16 bf16x2_t __attribute__((ext_vector_type(2)));
#define LDS_WAIT() asm volatile("s_waitcnt lgkmcnt(0)" ::: "memory")
#define VM_WAIT() asm volatile("s_waitcnt vmcnt(0)" ::: "memory")
DI unsigned pk2(float lo, float hi) { f32x2 v = {lo, hi}; bf16x2_t b = __builtin_convertvector(v, bf16x2_t); return __builtin_bit_cast(unsigned, b); }
DI float bf_lo(unsigned w) { return __uint_as_float(w << 16); }
DI float bf_hi(unsigned w) { return __uint_as_float(w & 0xffff0000u); }
DI float bf2f(bf16 b) { return __uint_as_float(((unsigned)b) << 16); }

#define XB_TMO      128
#define XB_XCNT(j)  (256  + 64 * (j))
#define XB_XSUB(j)  (1280 + 64 * (j))
#define XB_XGEN(j)  (2304 + 64 * (j))
#define XB_TOP      3328
#define XB_TOPGEN   3392
#define XCD_BAR_WORDS 3456
#define XB_SPIN_CAP (1u << 21)
DI unsigned xb_ld(unsigned* p)              { return __hip_atomic_load(p, __ATOMIC_RELAXED, __HIP_MEMORY_SCOPE_AGENT); }
DI unsigned xb_add(unsigned* p, unsigned v) { return __hip_atomic_fetch_add(p, v, __ATOMIC_RELAXED, __HIP_MEMORY_SCOPE_AGENT); }
DI unsigned xb_xcc_id() { return (unsigned)__builtin_amdgcn_s_getreg((3 << 11) | 20) & 0xFu; }
#define XB_SPIN(cond, bar) do { unsigned _sp = 0; while (cond) { __builtin_amdgcn_s_sleep(1); \
    if ((++_sp & 255u) == 0u) { if (xb_ld(&(bar)[XB_TMO])) break; if (_sp > XB_SPIN_CAP) { atomicAdd(&(bar)[XB_TMO], 1u); break; } } } } while (0)
DI unsigned long long ptab_get(LAS const unsigned long long* PT, int i) { const unsigned long long v = PT[i];
    const unsigned lo = __builtin_amdgcn_readfirstlane((unsigned)v), hi = __builtin_amdgcn_readfirstlane((unsigned)(v >> 32)); return ((unsigned long long)hi << 32) | lo; }
struct XcdBarrier { LAS const unsigned long long* pt; unsigned x; volatile LAS unsigned* st; };
DI unsigned* xb_words(LAS const unsigned long long* pt) { return (unsigned*)(GAS unsigned*)(ptab_get(pt, 26) + WS_CTL) + CW_BAR; }
DI XcdBarrier xcd_barrier_post(LAS const unsigned long long* pt, volatile LAS unsigned* st) {
    XcdBarrier b; b.pt = pt; b.x = xb_xcc_id(); b.st = st; unsigned* bar = xb_words(pt);
    if (threadIdx.x == 0) (void)xb_add(&bar[XB_XCNT(b.x)], 1u);
    return b;
}
DI void xcd_barrier_complete(unsigned* bar, unsigned x, unsigned& nloc, unsigned& nx) {
    const unsigned G = gridDim.x * gridDim.y * gridDim.z;
    unsigned sum, cnt, mine, sp = 0u;
    for (;;) {
        sum = 0u; cnt = 0u; mine = 0u;
#pragma unroll
        for (unsigned j = 0; j < 16; ++j) { const unsigned c = xb_ld(&bar[XB_XCNT(j)]); sum += c; cnt += (c > 0u) ? 1u : 0u; mine = (j == x) ? c : mine; }
        if (sum == G) break;
        __builtin_amdgcn_s_sleep(1);
        if ((++sp & 255u) == 0u) { if (xb_ld(&bar[XB_TMO])) break; if (sp > XB_SPIN_CAP) { atomicAdd(&bar[XB_TMO], 1u); break; } }
    }
    nloc = mine > 0u ? mine : 1u; nx = cnt > 0u ? cnt : 1u;
}
DI void xcd_barrier(const XcdBarrier& b) {
    asm volatile("s_waitcnt vmcnt(0)" ::: "memory");
    __syncthreads();
    if (threadIdx.x == 0) {
        unsigned* bar = xb_words(b.pt); const unsigned bx_ = xb_xcc_id();
        __builtin_amdgcn_s_waitcnt(0);
        unsigned nloc = b.st[0], nx = b.st[1];
        if (nloc == 0u) { xcd_barrier_complete(bar, bx_, nloc, nx); b.st[0] = nloc; b.st[1] = nx; }
        const unsigned old = xb_add(&bar[XB_XSUB(bx_)], 1u);
        const unsigned gen = old / nloc;
        if (old + 1u == (gen + 1u) * nloc) {
            __builtin_amdgcn_fence(__ATOMIC_RELEASE, "agent");
            asm volatile("s_waitcnt vmcnt(0)" ::: "memory");
            const unsigned og = xb_add(&bar[XB_TOP], 1u);
            const unsigned tg = og / nx;
            if (og + 1u == (tg + 1u) * nx) xb_add(&bar[XB_TOPGEN], 1u);
            else XB_SPIN(xb_ld(&bar[XB_TOPGEN]) == tg, bar);
            __builtin_amdgcn_fence(__ATOMIC_ACQUIRE, "agent");
            xb_add(&bar[XB_XGEN(bx_)], 1u);
            asm volatile("s_waitcnt vmcnt(0)" ::: "memory");
        } else {
            XB_SPIN(xb_ld(&bar[XB_XGEN(bx_)]) == gen, bar);
            __builtin_amdgcn_fence(__ATOMIC_ACQUIRE, "agent");
            asm volatile("s_waitcnt vmcnt(0)" ::: "memory");
        }
    }
    __syncthreads();
}
DI float shx(float v, int mask, int lane) { return __builtin_bit_cast(float, __builtin_amdgcn_ds_bpermute((lane ^ mask) << 2, __builtin_bit_cast(int, v))); }
DI float shi(float v, int src) { return __builtin_bit_cast(float, __builtin_amdgcn_ds_bpermute(src << 2, __builtin_bit_cast(int, v))); }
DI float wave_sum(float v, int lane) {
#pragma unroll
    for (int o = 1; o < 64; o <<= 1) v += shx(v, o, lane);
    return v;
}

struct Ctx { int tid, lane, wave, vcu, G, gw, NGW; };

template <int MAP> DI int map_src_col(int n0) {
    if (MAP == 1) { const int hc = n0 / QCW, rem = n0 % QCW, gt = rem / (HC * HD), rem2 = rem % (HC * HD), hl = rem2 / HD, d0 = rem2 % HD; return (gt * 16 + hc * HC + hl) * HD + d0; }
    if (MAP == 2) { const int ch = n0 / UCW, rem = n0 % UCW, p = rem / CCH, cl = rem % CCH; return p * D + ch * CCH + cl; }
    return n0;
}
DI void transpose_item(const float* W, int K, int Nsrc, bf16* WT, int n0dst, int n0src, int k0, LAS float* scr, int lane, const float* gain, bool perm, int hb) {
    const int r = lane >> 4, q = lane & 15;
    const int srcc = perm ? n0src + 32 * hb + (q < 8 ? 4 * q : 64 + 4 * (q - 8)) : n0src + 4 * q;
    f32x4 v[16];
#pragma unroll
    for (int i = 0; i < 16; ++i) v[i] = __builtin_nontemporal_load((const GAS f32x4*)(W + (size_t)(k0 + 4 * i + r) * Nsrc + srcc));
    if (gain) {
#pragma unroll
        for (int i = 0; i < 16; ++i) v[i] = v[i] * gain[k0 + 4 * i + r]; }
#pragma unroll
    for (int i = 0; i < 16; ++i) { LAS float* d = scr + (4 * i + r) * 65 + 4 * q; d[0] = v[i].x; d[1] = v[i].y; d[2] = v[i].z; d[3] = v[i].w; }
    LDS_WAIT(); asm volatile("" ::: "memory");
    const int c = lane & 7;
#pragma unroll
    for (int j = 0; j < 8; ++j) { const int n = (lane >> 3) + 8 * j; const LAS float* s = scr + (8 * c) * 65 + n;
        const int prow = perm ? 32 * ((n >> 4) & 1) + 8 * ((n >> 2) & 3) + 4 * (n >> 5) + (n & 3) : n;
        v4u o; o.x = pk2(s[0 * 65], s[1 * 65]); o.y = pk2(s[2 * 65], s[3 * 65]); o.z = pk2(s[4 * 65], s[5 * 65]); o.w = pk2(s[6 * 65], s[7 * 65]);
        *(GAS v4u*)(WT + (size_t)(n0dst + prow) * K + k0 + 8 * c) = o; }
    LDS_WAIT(); asm volatile("" ::: "memory");
}
template <int MAP> DI void convert_matrix(const Ctx& C, LAS float* scr, const float* W, int K, int Nsrc, int Ndst, bf16* WT, int& item_base, const float* gain) {
    const int nblk = Ndst / 64, nitems = (K / 64) * nblk;
    int first = C.gw - (item_base % C.NGW); if (first < 0) first += C.NGW;
    for (int it = first; it < nitems; it += C.NGW) { const int kb = it / nblk, nb = it % nblk;
        bool perm = false; int hb = 0, srcb = map_src_col<MAP>(nb * 64);
        if (MAP == 1) { const int rem = (nb * 64) % QCW, gt = rem / (HC * HD); perm = (gt % 3) != 2; hb = (nb * 64 % HD) / 64; if (perm) srcb -= 64 * hb; }
        transpose_item(W, K, Nsrc, WT, nb * 64, srcb, kb * 64, scr, C.lane, gain, perm, hb); }
    item_base += nitems;
}

DI void ph_x0(const Ctx& C, const float* xp, const float* xs, bf16* XB, float* SS) {
    for (int m = C.gw; m < M; m += C.NGW) {
        const float* src = (m < MP) ? xp + (size_t)m * D : xs + (size_t)(m - MP) * D;
        const GAS f32x4* xr = (const GAS f32x4*)src + C.lane;
        f32x4 v[8]; float s = 0.f;
#pragma unroll
        for (int j = 0; j < 8; ++j) { v[j] = xr[64 * j]; s += (v[j].x * v[j].x + v[j].y * v[j].y) + (v[j].z * v[j].z + v[j].w * v[j].w); }
        s = wave_sum(s, C.lane);
        GAS v2u* o8 = (GAS v2u*)(XB + (size_t)m * D) + C.lane;
#pragma unroll
        for (int j = 0; j < 8; ++j) { v2u o; o.x = pk2(v[j].x, v[j].y); o.y = pk2(v[j].z, v[j].w); o8[64 * j] = o; }
        if (C.lane < 8) SS[(size_t)m * 8 + C.lane] = C.lane == 0 ? s : 0.f;
    }
}
DI int row_pos(int m) { return (m < MP) ? (m & (LP - 1)) : ((m - MP) & (LS - 1)); }

constexpr float QSCALE = 0.08838834764831845f * 1.4426950408889634f;
DI void ph_qkprep(const Ctx& C, bf16* QKVC, const float* qgain  , const float* kgain  ) {
    const int sub = C.lane & 15, d0 = 4 * sub;
    float inv[4];
#pragma unroll
    for (int e = 0; e < 4; ++e) inv[e] = exp2f(-(float)(d0 + e) * (13.287712379549449f / 64.0f));
    constexpr int NIT = (6 * HC) / 4;
    for (int m = C.gw; m < M; m += C.NGW) {
        bf16* rowp = QKVC + (size_t)m * QCW;
        v2u ra[NIT], rb[NIT];
#pragma unroll
        for (int it = 0; it < NIT; ++it) { const int vv = it * 4 + (C.lane >> 4), gtt = vv / HC, hl = vv % HC, g = gtt >> 1, t = gtt & 1;
            const bf16* p = rowp + ((g * 3 + t) * HC + hl) * HD + d0; ra[it] = *(const GAS v2u*)p; rb[it] = *(const GAS v2u*)(p + 64); }
        const float pos = (float)row_pos(m);
        float cs[4], sn[4];
#pragma unroll
        for (int e = 0; e < 4; ++e) { const float ang = pos * inv[e]; float rev = ang * 0.15915494309189535f; rev -= floorf(rev); cs[e] = __builtin_amdgcn_cosf(rev); sn[e] = __builtin_amdgcn_sinf(rev); }
#pragma unroll
        for (int it = 0; it < NIT; ++it) {
            const int vv = it * 4 + (C.lane >> 4), gtt = vv / HC, hl = vv % HC, g = gtt >> 1, t = gtt & 1;
            bf16* p = rowp + ((g * 3 + t) * HC + hl) * HD + d0;
            const v2u a = ra[it], b = rb[it];
            float x1[4] = {bf_lo(a.x), bf_hi(a.x), bf_lo(a.y), bf_hi(a.y)}, x2[4] = {bf_lo(b.x), bf_hi(b.x), bf_lo(b.y), bf_hi(b.y)};
            float ss = 0.f;
#pragma unroll
            for (int e = 0; e < 4; ++e) ss += x1[e] * x1[e] + x2[e] * x2[e];
            ss += shx(ss, 1, C.lane); ss += shx(ss, 2, C.lane); ss += shx(ss, 4, C.lane); ss += shx(ss, 8, C.lane);
            float r = 1.0f / sqrtf(ss * (1.f / HD) + RMS_EPS);
            const float* gp = (t == 0 ? qgain : kgain) + g * HD + d0;
            const f32x4 g1 = *(const GAS f32x4*)gp, g2 = *(const GAS f32x4*)(gp + 64);
            if (t == 0) r *= QSCALE;
            float o1[4], o2[4];
#pragma unroll
            for (int e = 0; e < 4; ++e) { const float y1 = x1[e] * r * g1[e], y2 = x2[e] * r * g2[e]; o1[e] = y1 * cs[e] - y2 * sn[e]; o2[e] = y2 * cs[e] + y1 * sn[e]; }
            v2u oa, ob; oa.x = pk2(o1[0], o1[1]); oa.y = pk2(o1[2], o1[3]); ob.x = pk2(o2[0], o2[1]); ob.y = pk2(o2[2], o2[3]);
            *(GAS v2u*)p = oa; *(GAS v2u*)(p + 64) = ob;
        }
    }
}

#ifndef MK_OG_INPLACE
#define MK_OG_INPLACE 1
#endif
DI bf16* og_ptr(bf16* OG, int g, int tok, int hl) { return MK_OG_INPLACE ? OG + (size_t)tok * QCW + ((g * 3) * HC + hl) * HD : OG + ((size_t)g * M + tok) * (HC * HD) + hl * HD; }
DI int crow(int r, int hi) { return (r & 3) + 8 * (r >> 2) + 4 * hi; }
constexpr int VPITCH = 320, KPITCH = 272, KIMG_BYTES = 32 * KPITCH, ATT_WAVE_BYTES = KIMG_BYTES + 32 * VPITCH;
#define TR4(a, b, c, d, addr, o0, o1, o2, o3) asm volatile("ds_read_b64_tr_b16 %0, %4 offset:%c5\n\tds_read_b64_tr_b16 %1, %4 offset:%c6\n\tds_read_b64_tr_b16 %2, %4 offset:%c7\n\tds_read_b64_tr_b16 %3, %4 offset:%c8\n\ts_waitcnt lgkmcnt(0)" \
    : "=&v"(a), "=&v"(b), "=&v"(c), "=&v"(d) : "v"(addr), "i"(o0), "i"(o1), "i"(o2), "i"(o3) : "memory")
constexpr int ATT_SEG = 16, ATT_NT = M / 32, ATT_NSEG = ATT_NT / ATT_SEG;
constexpr int ATT_KS = 0, ATT_VS = 4 * KIMG_BYTES, ATT_QW = ATT_VS + 4 * 32 * VPITCH;
static_assert(ATT_QW + 8 * KIMG_BYTES <= SCRATCH_BYTES, "attention LDS map");
DI void attn_decode(int tt, int dsh, int& base_row, int& j, int& run_lo, int& run_hi) {
    int row0, w, sh, t0;
    if (tt < 256) { row0 = (tt >> 6) * LP; w = tt & 63; sh = 6 - dsh; } else { const int q = tt - 256; row0 = MP + (q >> 9) * LS; w = q & 511; sh = 9 - dsh; }
    t0 = tt - w; const int r = w >> sh; j = w & ((1 << sh) - 1); base_row = row0 + r; run_lo = t0 + (r << sh); run_hi = run_lo + (1 << sh);
}
DI void attn_segment(const bf16* QKVC, bf16* OG, float* LSE, int g, int hl, int seg, int t0, int nt, int wave, int tid, LAS unsigned char* lds, unsigned lds_addr) {
    const int lane = tid & 63;
    LAS unsigned char* kl = lds + ATT_QW + wave * KIMG_BYTES;
    const int dsh = 2 * g, dil = 1 << dsh;
    const int ql = lane & 31, hi = lane >> 5, lr = lane >> 4, lc = lane & 15, prow = tid >> 4, pch = tid & 15;
    const int qcol = ((g * 3 + 0) * HC + hl) * HD, kcol = ((g * 3 + 1) * HC + hl) * HD, vcol = ((g * 3 + 2) * HC + hl) * HD;
    const unsigned tr_off = (unsigned)((4 * hi + ((lane & 15) >> 2)) * VPITCH + ((lane >> 4) & 1) * 32 + (lane & 3) * 8);
    const int seg0 = seg * ATT_SEG + t0, c0 = seg0 - 2, clast = seg0 + nt + 1, nkq = nt >> 3;
    bf16x8 qf[8]; f32x16 o[4]; float mrun = -INFINITY, lrun = 0.f;
    int base_row = 0, jq = 0, run_lo = 0, run_hi = 0; bool started = false;
#pragma unroll
    for (int c = 0; c < 4; ++c)
#pragma unroll
        for (int i = 0; i < 16; ++i) o[c][i] = 0.f;
#pragma unroll
    for (int s = 0; s < 8; ++s) qf[s] = (bf16x8){0, 0, 0, 0, 0, 0, 0, 0};
#define ATT_LOADT(c_, kr_, vr_) do { kr_ = (v4u){0u, 0u, 0u, 0u}; vr_ = kr_; if ((c_) >= 0 && (c_) < ATT_NT) { int br_, j_, lo_, hi_; attn_decode((c_), dsh, br_, j_, lo_, hi_); \
        const bf16* rp_ = QKVC + (size_t)(br_ + dil * (32 * j_ + prow)) * QCW + 8 * pch; kr_ = __builtin_nontemporal_load((const GAS v4u*)(rp_ + kcol)); vr_ = __builtin_nontemporal_load((const GAS v4u*)(rp_ + vcol)); } } while (0)
    v4u kr0, vr0, kr1, vr1;
    ATT_LOADT(c0, kr0, vr0); ATT_LOADT(c0 + 1, kr1, vr1);
#define ATT_PAIR(c_, b_) do { \
        *(LAS v4u*)(lds + ATT_KS + (b_) * KIMG_BYTES + prow * KPITCH + pch * 16) = kr0; *(LAS v4u*)(lds + ATT_VS + (b_) * (32 * VPITCH) + prow * VPITCH + pch * 16) = vr0; \
        *(LAS v4u*)(lds + ATT_KS + ((b_) + 1) * KIMG_BYTES + prow * KPITCH + pch * 16) = kr1; *(LAS v4u*)(lds + ATT_VS + ((b_) + 1) * (32 * VPITCH) + prow * VPITCH + pch * 16) = vr1; \
        if ((c_) + 2 <= clast) { ATT_LOADT((c_) + 2, kr0, vr0); ATT_LOADT((c_) + 3, kr1, vr1); } \
        LDS_WAIT(); __builtin_amdgcn_s_barrier(); asm volatile("" ::: "memory"); \
        attn_tile((c_), (b_)); attn_tile((c_) + 1, (b_) + 1); } while (0)
    auto attn_tile = [&](int c, int b) __attribute__((always_inline)) {
        const int d = c - seg0 - wave + 2, kq = d >> 3, rem = d & 7;
        if (d < 0 || rem > 4 || kq >= nkq) return;
        const int cq = seg0 + wave + 8 * kq;
        if (!started) attn_decode(cq, dsh, base_row, jq, run_lo, run_hi);
        if (c < run_lo || c >= run_hi) return;
        if (!started) {
            started = true;
            v4u qraw[8];
#pragma unroll
            for (int it = 0; it < 8; ++it) qraw[it] = __builtin_nontemporal_load((const GAS v4u*)(QKVC + (size_t)(base_row + dil * (32 * jq + lr + 4 * it)) * QCW + qcol + 8 * lc));
#pragma unroll
            for (int it = 0; it < 8; ++it) *(LAS v4u*)(kl + (lr + 4 * it) * KPITCH + lc * 16) = qraw[it];
            LDS_WAIT();
#pragma unroll
            for (int s = 0; s < 8; ++s) qf[s] = *(const LAS bf16x8*)(kl + ql * KPITCH + 32 * s + 16 * hi);
            LDS_WAIT(); asm volatile("" ::: "memory");
#pragma unroll
            for (int cc = 0; cc < 4; ++cc)
#pragma unroll
                for (int i = 0; i < 16; ++i) o[cc][i] = 0.f;
            mrun = -INFINITY; lrun = 0.f;
        }
        const bool last_tile = (c == cq + 2) || (c == run_hi - 1);
        const LAS unsigned char* ks = lds + ATT_KS + b * KIMG_BYTES;
        bf16x8 kf[8];
#pragma unroll
        for (int s8 = 0; s8 < 8; ++s8) kf[s8] = *(const LAS bf16x8*)(ks + ql * KPITCH + 32 * s8 + 16 * hi);
        f32x16 s;
#pragma unroll
        for (int i = 0; i < 16; ++i) s[i] = 0.f;
        __builtin_amdgcn_s_setprio(1);
#pragma unroll
        for (int k8 = 0; k8 < 8; ++k8) s = __builtin_amdgcn_mfma_f32_32x32x16_bf16(kf[k8], qf[k8], s, 0, 0, 0);
        __builtin_amdgcn_s_setprio(0);
        if (c == cq - 2) {
#pragma unroll
            for (int i = 0; i < 16; ++i) if (crow(i, hi) < ql) s[i] = -INFINITY;
        } else if (c == cq + 2) {
#pragma unroll
            for (int i = 0; i < 16; ++i) if (crow(i, hi) > ql) s[i] = -INFINITY;
        }
        float mx = s[0];
#pragma unroll
        for (int i = 1; i < 16; ++i) mx = fmaxf(mx, s[i]);
        mx = fmaxf(mx, shx(mx, 32, lane));
        const float mnew = fmaxf(mrun, mx);
        if (__builtin_amdgcn_ballot_w64(mnew - mrun > 8.0f) != 0ull) {
            const float alpha = __builtin_amdgcn_exp2f(mrun - mnew);
            lrun *= alpha; mrun = mnew;
#pragma unroll
            for (int cc = 0; cc < 4; ++cc)
#pragma unroll
                for (int i = 0; i < 16; ++i) o[cc][i] *= alpha;
        }
        float ls = 0.f;
#pragma unroll
        for (int i = 0; i < 16; ++i) { s[i] = __builtin_amdgcn_exp2f(s[i] - mrun); ls += s[i]; }
        lrun += ls;
        bf16x8 pf[2];
#pragma unroll
        for (int sp = 0; sp < 2; ++sp) { v4u pw; pw.x = pk2(s[8 * sp + 0], s[8 * sp + 1]); pw.y = pk2(s[8 * sp + 2], s[8 * sp + 3]); pw.z = pk2(s[8 * sp + 4], s[8 * sp + 5]); pw.w = pk2(s[8 * sp + 6], s[8 * sp + 7]); pf[sp] = __builtin_bit_cast(bf16x8, pw); }
        const unsigned tr_base = lds_addr + (unsigned)(ATT_VS + b * (32 * VPITCH)) + tr_off;
        s16x4 ta[4][4];
#pragma unroll
        for (int cc = 0; cc < 4; ++cc)
            asm volatile("ds_read_b64_tr_b16 %0, %4 offset:%c5\n\tds_read_b64_tr_b16 %1, %4 offset:%c6\n\tds_read_b64_tr_b16 %2, %4 offset:%c7\n\tds_read_b64_tr_b16 %3, %4 offset:%c8"
                : "=&v"(ta[cc][0]), "=&v"(ta[cc][1]), "=&v"(ta[cc][2]), "=&v"(ta[cc][3]) : "v"(tr_base), "i"(64 * cc), "i"(8 * VPITCH + 64 * cc), "i"(16 * VPITCH + 64 * cc), "i"(24 * VPITCH + 64 * cc) : "memory");
        asm volatile("s_waitcnt lgkmcnt(0)" : "+v"(ta[0][0]), "+v"(ta[0][1]), "+v"(ta[0][2]), "+v"(ta[0][3]), "+v"(ta[1][0]), "+v"(ta[1][1]), "+v"(ta[1][2]), "+v"(ta[1][3]),
                                              "+v"(ta[2][0]), "+v"(ta[2][1]), "+v"(ta[2][2]), "+v"(ta[2][3]), "+v"(ta[3][0]), "+v"(ta[3][1]), "+v"(ta[3][2]), "+v"(ta[3][3]) :: "memory");
        __builtin_amdgcn_s_setprio(1);
#pragma unroll
        for (int cc = 0; cc < 4; ++cc) {
            const bf16x8 v0 = __builtin_shufflevector(ta[cc][0], ta[cc][1], 0, 1, 2, 3, 4, 5, 6, 7), v1 = __builtin_shufflevector(ta[cc][2], ta[cc][3], 0, 1, 2, 3, 4, 5, 6, 7);
            o[cc] = __builtin_amdgcn_mfma_f32_32x32x16_bf16(v0, pf[0], o[cc], 0, 0, 0);
            o[cc] = __builtin_amdgcn_mfma_f32_32x32x16_bf16(v1, pf[1], o[cc], 0, 0, 0);
        }
        __builtin_amdgcn_s_setprio(0);
        if (last_tile) {
            started = false;
            const float ltot = lrun + shx(lrun, 32, lane);
            const float rinv = 1.0f / ltot;
#pragma unroll
            for (int cc = 0; cc < 4; ++cc)
#pragma unroll
                for (int g4 = 0; g4 < 4; ++g4) { v2u w2; w2.x = pk2(o[cc][4 * g4] * rinv, o[cc][4 * g4 + 1] * rinv); w2.y = pk2(o[cc][4 * g4 + 2] * rinv, o[cc][4 * g4 + 3] * rinv);
                    *(LAS v2u*)(kl + ql * KPITCH + (32 * cc + 8 * g4 + 4 * hi) * 2) = w2; }
            LDS_WAIT(); asm volatile("" ::: "memory");
#pragma unroll
            for (int it = 0; it < 8; ++it) { const v4u ov = *(const LAS v4u*)(kl + (lr + 4 * it) * KPITCH + lc * 16);
                *(GAS v4u*)(og_ptr(OG, g, base_row + dil * (32 * jq + lr + 4 * it), hl) + 8 * lc) = ov; }
            LDS_WAIT(); asm volatile("" ::: "memory");
            if (hi == 0) LSE[((size_t)g * M + (size_t)(base_row + dil * (32 * jq + ql))) * HC + hl] = mrun + __builtin_amdgcn_logf(ltot);
        }
    };
    static_assert((ATT_SEG + 4) % 4 == 0, "pairs of pairs");
    for (int c = c0; c <= clast; c += 4) { ATT_PAIR(c, 0); ATT_PAIR(c + 2, 2); }
#undef ATT_LOADT
#undef ATT_PAIR
}
DI void ph_attn(const Ctx& C, const bf16* QKVC, bf16* OG, float* LSE, unsigned char* lds_generic) {
    const unsigned lds_addr = (unsigned)(size_t)(lds_generic);
    constexpr int NSU = 3 * HC * ATT_NSEG;
    const int nfull = (NSU / C.G) * C.G, rem_su = NSU - nfull; const bool halves = 2 * rem_su <= C.G;
    for (int su = C.vcu; su < (halves ? nfull : NSU); su += C.G) { const int g = su / (HC * ATT_NSEG), rem = su % (HC * ATT_NSEG);
        __syncthreads();
        attn_segment(QKVC, OG, LSE, g, rem / ATT_NSEG, rem % ATT_NSEG, 0, ATT_SEG, C.wave, C.tid, (LAS unsigned char*)lds_generic, lds_addr); }
    if (halves && C.vcu < 2 * rem_su) { const int su = nfull + (C.vcu >> 1), g = su / (HC * ATT_NSEG), rem = su % (HC * ATT_NSEG);
        __syncthreads();
        attn_segment(QKVC, OG, LSE, g, rem / ATT_NSEG, rem % ATT_NSEG, 8 * (C.vcu & 1), 8, C.wave, C.tid, (LAS unsigned char*)lds_generic, lds_addr); }
    __syncthreads();
}
#ifndef CMB_RB
#define CMB_RB 4
#endif
DI void ph_combine(const Ctx& C, const bf16* OG, const float* LSE, bf16* AO, int hc) {
    const int d0 = (C.lane & 15) * 8;
    constexpr int RB = CMB_RB, NS = RB * (HC / 4);
    for (int m0 = C.gw; m0 < M; m0 += RB * C.NGW) {
        float ls[NS][3]; v4u og[NS][3];
#pragma unroll
        for (int q = 0; q < NS; ++q) { const int mm = m0 + (q / (HC / 4)) * C.NGW, m = mm < M ? mm : m0, hl = (q % (HC / 4)) * 4 + (C.lane >> 4);
#pragma unroll
            for (int g = 0; g < 3; ++g) { ls[q][g] = LSE[((size_t)g * M + m) * HC + hl]; og[q][g] = *(const GAS v4u*)(og_ptr((bf16*)OG, g, m, hl) + d0); } }
#pragma unroll
        for (int q = 0; q < NS; ++q) { const int m = m0 + (q / (HC / 4)) * C.NGW, hl = (q % (HC / 4)) * 4 + (C.lane >> 4);
            const float mx = fmaxf(ls[q][0], fmaxf(ls[q][1], ls[q][2]));
            float w[3]; float ws = 0.f;
#pragma unroll
            for (int g = 0; g < 3; ++g) { w[g] = __builtin_amdgcn_exp2f(ls[q][g] - mx); ws += w[g]; }
            const float rw = 1.0f / ws;
            float acc[8] = {0.f, 0.f, 0.f, 0.f, 0.f, 0.f, 0.f, 0.f};
#pragma unroll
            for (int g = 0; g < 3; ++g) { const float wg = w[g] * rw; const unsigned qq[4] = {og[q][g].x, og[q][g].y, og[q][g].z, og[q][g].w};
#pragma unroll
                for (int e = 0; e < 4; ++e) { acc[2 * e] += wg * bf_lo(qq[e]); acc[2 * e + 1] += wg * bf_hi(qq[e]); } }
            v4u o; o.x = pk2(acc[0], acc[1]); o.y = pk2(acc[2], acc[3]); o.z = pk2(acc[4], acc[5]); o.w = pk2(acc[6], acc[7]);
            if (m < M) *(GAS v4u*)(AO + (size_t)m * D + (hc * HC + hl) * HD + d0) = o;
        }
    }
}

DI void ph_filter_hidden(const Ctx& C, const float* w1, const float* b1, const float* w2, const float* b2, const float* w3, const float* b3, const float* fr, float* H3f) {
    bf16* const H3 = (bf16*)H3f;
    const int lane = C.lane;
    const float frq = fr[lane], bb1 = b1[lane], bb2 = b2[lane], bb3 = b3[lane];
    for (int pi = C.gw; pi < NPOS; pi += C.NGW) {
        const int Lk = pi < LP ? LP : LS; const float pos = (float)(pi < LP ? pi : pi - LP);
        const float t = pos / (float)(Lk - 1);
        float z = 0.f;
        if (lane == 0) z = t;
        else if (lane <= 32) { const int k = (lane - 1) & 15; const float band = 1e-4f + (float)k * ((15.0f - 1e-4f) / 15.0f); const float ang = ((float)(6.283185307179586 / (double)Lk) * pos) * band; z = lane <= 16 ? cosf(ang) : -sinf(ang); }
        float a = bb1;
#pragma unroll
        for (int i = 0; i < 33; ++i) a += __builtin_bit_cast(float, __builtin_amdgcn_readlane(__builtin_bit_cast(int, z), i)) * w1[i * 64 + lane];
        float h = sinf(frq * a);
        a = bb2;
#pragma unroll 16
        for (int i = 0; i < 64; ++i) a += __builtin_bit_cast(float, __builtin_amdgcn_readlane(__builtin_bit_cast(int, h), i)) * w2[i * 64 + lane];
        h = sinf(frq * a);
        a = bb3;
#pragma unroll 16
        for (int i = 0; i < 64; ++i) a += __builtin_bit_cast(float, __builtin_amdgcn_readlane(__builtin_bit_cast(int, h), i)) * w3[i * 64 + lane];
        h = sinf(frq * a);
        { const unsigned hw = pk2(h, 0.f); H3[(size_t)pi * 64 + lane] = __builtin_bit_cast(bf16, (unsigned short)(hw & 0xffffu)); }
    }
}
DI void ph_filter_gen(const Ctx& C, unsigned char* lds_generic, const float* H3f, const float* w4  , unsigned* HT, int ch) {
    const bf16* const H3 = (const bf16*)H3f;
    LAS unsigned short* wl = (LAS unsigned short*)lds_generic;
    constexpr int NCOL = 2 * CCH, WP = 72, CB = 512, NPT = NPOS / 32, NCT = CB / 32;
    const int ql = C.lane & 31, hi = C.lane >> 5;
    constexpr int NCB = NCOL / CB;
    const bool split = (C.G % NCB) == 0;
    const int cb_lo = split ? C.vcu % NCB : 0, cb_hi = split ? cb_lo + 1 : NCB;
    const int gwl = split ? (C.vcu / NCB) * NWAVES + C.wave : C.gw, ngwl = split ? (C.G / NCB) * NWAVES : C.NGW;
    for (int cb = cb_lo; cb < cb_hi; ++cb) {
        __syncthreads();
        { const int q = cb * CB + C.tid, dir = q / CCH, cl = q % CCH; const float* wp = w4 + dir * D + ch * CCH + cl;
#pragma unroll 1
          for (int ib = 0; ib < 4; ++ib) { float wv[16];
#pragma unroll
              for (int t = 0; t < 16; ++t) wv[t] = wp[(size_t)(ib * 16 + t) * (2 * D)];
              v4u p0, p1; p0.x = pk2(wv[0], wv[1]); p0.y = pk2(wv[2], wv[3]); p0.z = pk2(wv[4], wv[5]); p0.w = pk2(wv[6], wv[7]); p1.x = pk2(wv[8], wv[9]); p1.y = pk2(wv[10], wv[11]); p1.z = pk2(wv[12], wv[13]); p1.w = pk2(wv[14], wv[15]);
              *(LAS v4u*)(wl + C.tid * WP + ib * 16) = p0; *(LAS v4u*)(wl + C.tid * WP + ib * 16 + 8) = p1; } }
        __syncthreads();
        v4u hb[4];
        if (gwl < NPT * NCT) { const int pi = (gwl / NCT) * 32 + ql;
#pragma unroll
            for (int s = 0; s < 4; ++s) hb[s] = *(const GAS v4u*)(H3 + (size_t)pi * 64 + 16 * s + 8 * hi); }
        for (int wt = gwl; wt < NPT * NCT; wt += ngwl) {
            const int pt = wt / NCT, ct = wt % NCT, pi = pt * 32 + ql;
            const int Lk = pi < LP ? LP : LS; const float pos = (float)(pi < LP ? pi : pi - LP), t = pos / (float)(Lk - 1), sc = 1.0f / (float)(2 * Lk);
            v4u hc[4];
#pragma unroll
            for (int s = 0; s < 4; ++s) hc[s] = hb[s];
            if (wt + ngwl < NPT * NCT) { const int pi2 = ((wt + ngwl) / NCT) * 32 + ql;
#pragma unroll
                for (int s = 0; s < 4; ++s) hb[s] = *(const GAS v4u*)(H3 + (size_t)pi2 * 64 + 16 * s + 8 * hi); }
            f32x16 acc;
#pragma unroll
            for (int i = 0; i < 16; ++i) acc[i] = 0.f;
#pragma unroll
            for (int s = 0; s < 4; ++s) {
                const bf16x8 a = *(const LAS bf16x8*)(wl + (ct * 32 + ql) * WP + 16 * s + 8 * hi);
                acc = __builtin_amdgcn_mfma_f32_32x32x16_bf16(a, __builtin_bit_cast(bf16x8, hc[s]), acc, 0, 0, 0);
            }
#pragma unroll
            for (int i = 0; i < 16; i += 2) { const int q = cb * CB + ct * 32 + crow(i, hi), dir = q / CCH, cl = q % CCH, c = ch * CCH + cl;
                const float d0 = fabsf(-3.0701134573253945f + (float)c * ((-15.350567286626972f + 3.0701134573253945f) / 2047.0f)), d1 = fabsf(-3.0701134573253945f + (float)(c + 1) * ((-15.350567286626972f + 3.0701134573253945f) / 2047.0f));
                HT[((size_t)cl + dir) * NPOS + pi] = pk2(acc[i] * __expf(-t * d0) * sc, acc[i + 1] * __expf(-t * d1) * sc); }
        }
    }
    __syncthreads();
}
DI void pair_geom(int ps, int& rowA, int& rowB, int& Lq, int& pp0) { if (ps == 0) { rowA = 0; rowB = LP; Lq = LP; pp0 = 0; } else if (ps == 1) { rowA = 2 * LP; rowB = 3 * LP; Lq = LP; pp0 = LP; } else { rowA = MP; rowB = MP + LS; Lq = LS; pp0 = 2 * LP; } }
struct GateGeom { int ct, ppt, rowA, rowB, Lq, t; bool valid; };
DI GateGeom gate_geom(const Ctx& C, int i, bool fastmap, int tl) {
    constexpr int NTT = PPOS / 64, NCT = CCH / 64;
    GateGeom g; int ptile;
    if (fastmap) { g.ct = C.vcu % NCT; ptile = C.vcu / NCT + (C.G / NCT) * i; } else { const int un = C.vcu + C.G * i; g.ct = un % NCT; ptile = un / NCT; }
    g.valid = ptile < NTT; if (!g.valid) ptile = 0;
    g.ppt = ptile * 64;
    const int ps = g.ppt < LP ? 0 : (g.ppt < 2 * LP ? 1 : 2);
    int pp0; pair_geom(ps, g.rowA, g.rowB, g.Lq, pp0);
    g.t = g.ppt - pp0 + tl;
    return g;
}
#define GATE_LOAD(gg) do { const int tm_ = (gg).t > 0 ? (gg).t - 1 : 0, tp_ = (gg).t < (gg).Lq - 1 ? (gg).t + 1 : (gg).Lq - 1; \
    _Pragma("unroll") for (int bb = 0; bb < 2; ++bb) { const bf16* ub = U + (size_t)(bb ? (gg).rowB : (gg).rowA) * UCW + (gg).ct * 64 + c8 * 8; \
    _Pragma("unroll") for (int p = 1; p < 3; ++p) { raw[bb][p - 1][0] = *(const GAS v4u*)(ub + (size_t)tm_ * UCW + p * CCH); raw[bb][p - 1][1] = *(const GAS v4u*)(ub + (size_t)(gg).t * UCW + p * CCH); raw[bb][p - 1][2] = *(const GAS v4u*)(ub + (size_t)tp_ * UCW + p * CCH); } } } while (0)
DI void ph_gate(const Ctx& C, unsigned char* lds_generic, const bf16* U, const float* cw  , const float* cb  , unsigned* ZC, unsigned* X0C, int ch) {
    LAS unsigned* zt = (LAS unsigned*)lds_generic;
    LAS unsigned* xt = zt + 64 * 65;
    LAS float* wl = (LAS float*)(xt + 64 * 65);
    constexpr int NTT = PPOS / 64, NCT = CCH / 64;
    const int tl = C.tid >> 3, c8 = C.tid & 7;
    const bool fastmap = (C.G % NCT) == 0;
    const int nun = fastmap ? NTT / (C.G / NCT) + ((NTT % (C.G / NCT)) ? 1 : 0) : (NTT * NCT + C.G - 1) / C.G;
    int ct_loaded = -1;
    v4u raw[2][2][3];
    { const GateGeom g0 = gate_geom(C, 0, fastmap, tl); if (g0.valid) GATE_LOAD(g0); }
    for (int i = 0; i < nun; ++i) {
        const GateGeom g = gate_geom(C, i, fastmap, tl);
        if (!g.valid) break;
        const int ct = g.ct, ppt = g.ppt, t = g.t, Lq = g.Lq, c0 = ch * CCH + ct * 64;
        __syncthreads();
        if (ct != ct_loaded) { ct_loaded = ct;
            for (int e = C.tid; e < 64 * 12; e += NTHR) { const int c = e / 12, r = e % 12, p = r >> 2, k = r & 3; wl[e] = k < 3 ? cw[(size_t)k * (3 * D) + p * D + c0 + c] : cb[p * D + c0 + c]; }
            __syncthreads(); }
        const float m0 = t > 0 ? 1.f : 0.f, m2 = t < Lq - 1 ? 1.f : 0.f;
#pragma unroll
        for (int e = 0; e < 8; ++e) {
            const f32x4 w1 = *(const LAS f32x4*)(wl + (c8 * 8 + e) * 12 + 4), w2 = *(const LAS f32x4*)(wl + (c8 * 8 + e) * 12 + 8);
            f32x2 zz;
#pragma unroll
            for (int bb = 0; bb < 2; ++bb) {
                float part[3];
#pragma unroll
                for (int p = 1; p < 3; ++p) { const f32x4 w = p == 1 ? w1 : w2;
                    const unsigned a = e < 2 ? raw[bb][p - 1][0].x : e < 4 ? raw[bb][p - 1][0].y : e < 6 ? raw[bb][p - 1][0].z : raw[bb][p - 1][0].w;
                    const unsigned b = e < 2 ? raw[bb][p - 1][1].x : e < 4 ? raw[bb][p - 1][1].y : e < 6 ? raw[bb][p - 1][1].z : raw[bb][p - 1][1].w;
                    const unsigned c = e < 2 ? raw[bb][p - 1][2].x : e < 4 ? raw[bb][p - 1][2].y : e < 6 ? raw[bb][p - 1][2].z : raw[bb][p - 1][2].w;
                    const float ua = (e & 1) ? bf_hi(a) : bf_lo(a), ub_ = (e & 1) ? bf_hi(b) : bf_lo(b), uc = (e & 1) ? bf_hi(c) : bf_lo(c);
                    part[p] = ua * m0 * w.x + ub_ * w.y + uc * m2 * w.z + w.w; }
                const float z = part[2] * part[1];
                if (bb == 0) zz.x = z; else zz.y = z;
            }
            zt[(c8 * 8 + e) * 65 + tl] = pk2(zz.x, zz.y);
        }
        if (i + 1 < nun) { const GateGeom gn = gate_geom(C, i + 1, fastmap, tl); if (gn.valid) GATE_LOAD(gn); }
        __syncthreads();
#pragma unroll
        for (int k = 0; k < 8; ++k) { const int cc = C.wave * 8 + k; const size_t o = (size_t)(ct * 64 + cc) * PPOS + ppt + C.lane; ZC[o] = zt[cc * 65 + C.lane]; }
    }
    __syncthreads();
}
DI void ph_ytrans(const Ctx& C, unsigned char* lds_generic, const unsigned* YC, const bf16* U, const float* cw  , const float* cb  , bf16* AO, int ch) {
    LAS unsigned* tl = (LAS unsigned*)lds_generic;
    LAS float* wl = (LAS float*)(tl + 64 * 65);
    constexpr int NTT = PPOS / 64, NCT = CCH / 64;
    const int pos = C.tid >> 3, c8 = C.tid & 7;
    unsigned v[8]; v4u xr[2][3];
#define YT_LOAD(un_) do { const int ct_ = (un_) % NCT, ppt_ = ((un_) / NCT) * 64; \
        _Pragma("unroll") for (int i = 0; i < 8; ++i) v[i] = YC[(size_t)(ct_ * 64 + C.wave * 8 + i) * PPOS + ppt_ + C.lane]; \
        const int ps_ = ppt_ < LP ? 0 : (ppt_ < 2 * LP ? 1 : 2); int rA_, rB_, Lq_, pp0_; pair_geom(ps_, rA_, rB_, Lq_, pp0_); const int t_ = ppt_ - pp0_ + pos, tm_ = t_ > 0 ? t_ - 1 : 0, tp_ = t_ < Lq_ - 1 ? t_ + 1 : Lq_ - 1; \
        _Pragma("unroll") for (int bb = 0; bb < 2; ++bb) { const bf16* ub = U + (size_t)(bb ? rB_ : rA_) * UCW + ct_ * 64 + c8 * 8; \
            xr[bb][0] = *(const GAS v4u*)(ub + (size_t)tm_ * UCW); xr[bb][1] = *(const GAS v4u*)(ub + (size_t)t_ * UCW); xr[bb][2] = *(const GAS v4u*)(ub + (size_t)tp_ * UCW); } } while (0)
    if (C.vcu < NTT * NCT) YT_LOAD(C.vcu);
    int ct_loaded = -1;
    for (int un = C.vcu; un < NTT * NCT; un += C.G) {
        const int ct = un % NCT, ptile = un / NCT, ppt = ptile * 64;
        const int ps = ppt < LP ? 0 : (ppt < 2 * LP ? 1 : 2);
        int rowA, rowB, Lq, pp0; pair_geom(ps, rowA, rowB, Lq, pp0);
        const int t = ppt - pp0 + pos, c0 = ch * CCH + ct * 64;
        __syncthreads();
        if (ct != ct_loaded) { ct_loaded = ct; if (C.tid < 256) { const int c = C.tid >> 2, k = C.tid & 3; wl[C.tid] = k < 3 ? cw[(size_t)k * (3 * D) + c0 + c] : cb[c0 + c]; } }
#pragma unroll
        for (int i = 0; i < 8; ++i) tl[(C.wave * 8 + i) * 65 + C.lane] = v[i];
        __syncthreads();
        const float m0 = t > 0 ? 1.f : 0.f, m2 = t < Lq - 1 ? 1.f : 0.f;
        float x0p[2][8];
#pragma unroll
        for (int e = 0; e < 8; ++e) { const f32x4 w = *(const LAS f32x4*)(wl + (c8 * 8 + e) * 4);
#pragma unroll
            for (int bb = 0; bb < 2; ++bb) {
                const unsigned a = e < 2 ? xr[bb][0].x : e < 4 ? xr[bb][0].y : e < 6 ? xr[bb][0].z : xr[bb][0].w;
                const unsigned b = e < 2 ? xr[bb][1].x : e < 4 ? xr[bb][1].y : e < 6 ? xr[bb][1].z : xr[bb][1].w;
                const unsigned c = e < 2 ? xr[bb][2].x : e < 4 ? xr[bb][2].y : e < 6 ? xr[bb][2].z : xr[bb][2].w;
                const float ua = (e & 1) ? bf_hi(a) : bf_lo(a), ub_ = (e & 1) ? bf_hi(b) : bf_lo(b), uc = (e & 1) ? bf_hi(c) : bf_lo(c);
                x0p[bb][e] = ua * m0 * w.x + ub_ * w.y + uc * m2 * w.z + w.w; } }
        float ya[8], yb[8];
#pragma unroll
        for (int e = 0; e < 8; ++e) { const unsigned w = tl[(c8 * 8 + e) * 65 + pos]; ya[e] = bf_lo(w) * x0p[0][e]; yb[e] = bf_hi(w) * x0p[1][e]; }
        { const int un2 = un + C.G; if (un2 < NTT * NCT) YT_LOAD(un2); }
        v4u oa, ob; oa.x = pk2(ya[0], ya[1]); oa.y = pk2(ya[2], ya[3]); oa.z = pk2(ya[4], ya[5]); oa.w = pk2(ya[6], ya[7]); ob.x = pk2(yb[0], yb[1]); ob.y = pk2(yb[2], yb[3]); ob.z = pk2(yb[4], yb[5]); ob.w = pk2(yb[6], yb[7]);
        *(GAS v4u*)(AO + (size_t)(rowA + t) * D + c0 + c8 * 8) = oa;
        *(GAS v4u*)(AO + (size_t)(rowB + t) * D + c0 + c8 * 8) = ob;
    }
#undef YT_LOAD
    __syncthreads();
}

typedef f32x2 cf;
DI cf unpk(unsigned w) { return (cf){bf_lo(w), bf_hi(w)}; }
DI cf cmul(cf a, cf b) { return (cf){a.x * b.x - a.y * b.y, a.x * b.y + a.y * b.x}; }
DI cf cis_rev(float rev) { return (cf){__builtin_amdgcn_cosf(rev), __builtin_amdgcn_sinf(rev)}; }
template <bool INV> DI cf rot90(cf a) { return INV ? (cf){-a.y, a.x} : (cf){a.y, -a.x}; }
template <bool INV> DI void dft4(cf& x0, cf& x1, cf& x2, cf& x3) {
    const cf a = x0 + x2, b = x0 - x2, c = x1 + x3, d = rot90<INV>(x1 - x3);
    x0 = a + c; x1 = b + d; x2 = a - c; x3 = b - d;
}
#define FC_C1 0.9238795325112867f
#define FC_S1 0.3826834323650898f
#define FC_H  0.7071067811865476f
template <bool INV> DI cf w16(int k) {
    const float c = k == 0 ? 1.f : k == 1 ? FC_C1 : k == 2 ? FC_H : k == 3 ? FC_S1 : k == 4 ? 0.f : k == 5 ? -FC_S1 : k == 6 ? -FC_H : k == 7 ? -FC_C1 : k == 8 ? -1.f : -FC_C1;
    const float s = k == 0 ? 0.f : k == 1 ? FC_S1 : k == 2 ? FC_H : k == 3 ? FC_C1 : k == 4 ? 1.f : k == 5 ? FC_C1 : k == 6 ? FC_H : k == 7 ? FC_S1 : k == 8 ? 0.f : -FC_S1;
    return (cf){c, INV ? s : -s};
}
template <bool INV> DI void dft_nat(cf (&x)[4]) { dft4<INV>(x[0], x[1], x[2], x[3]); }
template <bool INV> DI void dft_nat(cf (&x)[8]) {
    cf a0 = x[0], a1 = x[2], a2 = x[4], a3 = x[6]; dft4<INV>(a0, a1, a2, a3);
    cf b0 = x[1], b1 = x[3], b2 = x[5], b3 = x[7]; dft4<INV>(b0, b1, b2, b3);
    b1 = cmul(b1, w16<INV>(2)); b2 = rot90<INV>(b2); b3 = cmul(b3, w16<INV>(6));
    x[0] = a0 + b0; x[4] = a0 - b0; x[1] = a1 + b1; x[5] = a1 - b1; x[2] = a2 + b2; x[6] = a2 - b2; x[3] = a3 + b3; x[7] = a3 - b3;
}
template <bool INV> DI void dft_nat(cf (&x)[16]) {
    cf a[4][4];
#pragma unroll
    for (int j1 = 0; j1 < 4; ++j1) { a[j1][0] = x[j1]; a[j1][1] = x[j1 + 4]; a[j1][2] = x[j1 + 8]; a[j1][3] = x[j1 + 12]; dft4<INV>(a[j1][0], a[j1][1], a[j1][2], a[j1][3]); }
#pragma unroll
    for (int j1 = 1; j1 < 4; ++j1)
#pragma unroll
        for (int m = 1; m < 4; ++m) a[j1][m] = cmul(a[j1][m], w16<INV>(j1 * m));
#pragma unroll
    for (int m = 0; m < 4; ++m) { dft4<INV>(a[0][m], a[1][m], a[2][m], a[3][m]); x[m] = a[0][m]; x[m + 4] = a[1][m]; x[m + 8] = a[2][m]; x[m + 12] = a[3][m]; }
}
template <int R, bool INV> DI void twiddle(cf (&x)[R], float rev) {
    asm volatile("" : "+v"(rev));
    cf w[R];
    w[1] = cis_rev(INV ? rev : -rev);
#pragma unroll
    for (int m = 2; m < R; ++m) w[m] = (m & 1) ? cmul(w[m - 1], w[1]) : cmul(w[m >> 1], w[m >> 1]);
#pragma unroll
    for (int m = 1; m < R; ++m) x[m] = cmul(x[m], w[m]);
}
DI int pidx(int i) { return i + ((i >> 6) << 2); }
constexpr int TW_OFF = 17408;
template <int N> DI constexpr int tw_base() { return N == 1024 ? TW_OFF : (N == 64 ? TW_OFF + 1024 : TW_OFF + 1024 + 64); }
template <int N> DI constexpr bool tw_has() { return N == 1024 || N == 64 || N == 128; }
typedef LAS cf* ldscf;
template <int S> DI constexpr int poff(int m) { return m * S + (((m * S) >> 6) << 2); }
#define FFT_OPAQUE(v) asm volatile("" : "+v"(v))
#define FFT_ULOOP(T, R) constexpr int NB_ = (T) / (R), NI_ = NB_ >= NTHR ? NB_ / NTHR : 1; _Pragma("unroll") for (int i_ = 0; i_ < NI_; ++i_) if (NB_ >= NTHR || tid < NB_)
template <int T, int N, int R, bool INV> DI void fft_pass_lds(ldscf lds, int tid) {
    constexpr int S = N / R, NB = T / R, NI = NB >= NTHR ? NB / NTHR : 1;
    if (NB < NTHR && tid >= NB) return;
    cf x[NI][R], w[NI][R]; int p0[NI], kk[NI];
#pragma unroll
    for (int i = 0; i < NI; ++i) { const int u = tid + NTHR * i, b = u / S, k = u % S; kk[i] = k; p0[i] = pidx(b * N + k); FFT_OPAQUE(p0[i]); int tk = tw_base<N>() + k; FFT_OPAQUE(tk);
#pragma unroll
        for (int m = 0; m < R; ++m) x[i][m] = lds[p0[i] + poff<S>(m)];
        if constexpr (tw_has<N>()) {
#pragma unroll
            for (int m = 1; m < R; ++m) w[i][m] = lds[tk + m * S]; } }
    __builtin_amdgcn_sched_barrier(0);
#pragma unroll
    for (int i = 0; i < NI; ++i) {
        if (!INV) { dft_nat<false>(x[i]);
            if constexpr (tw_has<N>()) {
#pragma unroll
                for (int m = 1; m < R; ++m) x[i][m] = cmul(x[i][m], w[i][m]);
            } else if (N != R) twiddle<R, false>(x[i], (float)kk[i] * (1.0f / N)); }
        else {
            if constexpr (tw_has<N>()) {
#pragma unroll
                for (int m = 1; m < R; ++m) x[i][m] = cmul(x[i][m], (cf){w[i][m].x, -w[i][m].y});
            } else if (N != R) twiddle<R, true>(x[i], (float)kk[i] * (1.0f / N));
            dft_nat<true>(x[i]); } }
#pragma unroll
    for (int i = 0; i < NI; ++i)
#pragma unroll
        for (int m = 0; m < R; ++m) lds[p0[i] + poff<S>(m)] = x[i][m];
}
#ifndef LAST_PD
#define LAST_PD 2
#endif
#ifndef FFT_REP_S
#define FFT_REP_S 1
#endif
#ifndef FFT_REP_P
#define FFT_REP_P 1
#endif
#ifndef FFTX_PROMPT
#define FFTX_PROMPT 8
#endif
#ifndef FFTX_MID
#define FFTX_MID 1
#endif
#ifndef FFTX_FIRST
#define FFTX_FIRST 1
#endif
#ifndef FFT_PROBE_FIRST
#define FFT_PROBE_FIRST 0
#endif
#ifndef FFT_PROBE_LAST
#define FFT_PROBE_LAST 0
#endif
#ifndef FFT_PROBE_MID
#define FFT_PROBE_MID 0
#endif
#define FFT_PROBE_SCALE (FFT_PROBE_MID == 1 ? 1.0f / 256.0f : 1.0f / 65536.0f)
constexpr int FA_OFF = TW_OFF + 16 * (64 + 4 + 8);
DI float fft_cos16(int n) { const int r = n & 7; const float b = r == 0 ? 1.f : r == 1 ? FC_C1 : r == 2 ? FC_H : r == 3 ? FC_S1 : r == 4 ? 0.f : r == 5 ? -FC_S1 : r == 6 ? -FC_H : -FC_C1; return (n & 8) ? -b : b; }
DI void fft_build_amat(ldscf A, int tid) {
    if (tid < 64) { const int m = tid & 31, h = tid >> 5, half = m >> 4, mm = m & 15, o = (mm & 3) | (((mm >> 3) & 1) << 2) | (((mm >> 2) & 1) << 3);
        float a0[8], a1[8];
#pragma unroll
        for (int j = 0; j < 8; ++j) { const int n = (o * (8 * h + j)) & 15; const float c = fft_cos16(n), sn = fft_cos16(n - 4); a0[j] = half ? -sn : c; a1[j] = half ? c : sn; }
        v4u h0, l0, h1, l1;
#pragma unroll
        for (int q = 0; q < 4; ++q) { const unsigned w0 = pk2(a0[2 * q], a0[2 * q + 1]), w1 = pk2(a1[2 * q], a1[2 * q + 1]);
            h0[q] = w0; l0[q] = pk2(a0[2 * q] - bf_lo(w0), a0[2 * q + 1] - bf_hi(w0)); h1[q] = w1; l1[q] = pk2(a1[2 * q] - bf_lo(w1), a1[2 * q + 1] - bf_hi(w1)); }
        LAS v4u* t = (LAS v4u*)(A + FA_OFF);
        t[tid] = h0; t[64 + tid] = l0; t[128 + tid] = h1; t[192 + tid] = l1; }
}
template <bool INV> DI void fft_mfma16(const cf (&x)[8], cf (&y)[8], const bf16x8 (&am)[4]) {
    v4u re, im;
#pragma unroll
    for (int q = 0; q < 4; ++q) { re[q] = pk2(x[2 * q].x, x[2 * q + 1].x); im[q] = pk2(x[2 * q].y, x[2 * q + 1].y); }
    const bf16x8 b0 = __builtin_bit_cast(bf16x8, INV ? im : re), b1 = __builtin_bit_cast(bf16x8, INV ? re : im);
    f32x16 acc;
#pragma unroll
    for (int i = 0; i < 16; ++i) acc[i] = 0.f;
    acc = __builtin_amdgcn_mfma_f32_32x32x16_bf16(am[0], b0, acc, 0, 0, 0);
    acc = __builtin_amdgcn_mfma_f32_32x32x16_bf16(am[2], b1, acc, 0, 0, 0);
    acc = __builtin_amdgcn_mfma_f32_32x32x16_bf16(am[1], b0, acc, 0, 0, 0);
    acc = __builtin_amdgcn_mfma_f32_32x32x16_bf16(am[3], b1, acc, 0, 0, 0);
#pragma unroll
    for (int j = 0; j < 8; ++j) y[j] = INV ? (cf){acc[8 + j], acc[j]} : (cf){acc[j], acc[8 + j]};
}
DI void fft_load_amat(ldscf lds, int lane, bf16x8 (&am)[4]) {
    int fo = FA_OFF * 2 + lane * 4; FFT_OPAQUE(fo);
    const LAS unsigned* t = (const LAS unsigned*)lds + fo;
#pragma unroll
    for (int q = 0; q < 4; ++q) am[q] = __builtin_bit_cast(bf16x8, *(const LAS v4u*)(t + q * 256));
}
template <int T, int N, bool INV> DI void fft_pass_mfma(ldscf lds, int tid) {
    constexpr int S = N / 16, NI = T / 16 / NTHR, NW = S > 32 ? 2 : 1;
    static_assert(NI >= 1 && tw_has<N>() && S <= 64, "table twiddles only");
    const int lane = tid & 63, h = lane >> 5, c = lane & 31, wb = tid & ~63;
    bf16x8 am[4]; fft_load_amat(lds, lane, am);
    cf x[NI][2][8], w[NW][8]; int p0[NI][2];
#pragma unroll
    for (int i = 0; i < NI; ++i)
#pragma unroll
        for (int cb = 0; cb < 2; ++cb) { const int u = wb + 32 * cb + c + NTHR * i, b = u / S, k = u % S; p0[i][cb] = pidx(b * N + k) + h * poff<S>(8); FFT_OPAQUE(p0[i][cb]);
#pragma unroll
            for (int j = 0; j < 8; ++j) x[i][cb][j] = lds[p0[i][cb] + poff<S>(j)];
            if (i == 0 && cb < NW) { int tk = tw_base<N>() + k + 8 * h * S; FFT_OPAQUE(tk);
#pragma unroll
                for (int j = 0; j < 8; ++j) w[cb][j] = lds[tk + j * S]; } }
    __builtin_amdgcn_sched_barrier(0);
#pragma unroll
    for (int i = 0; i < NI; ++i)
#pragma unroll
        for (int cb = 0; cb < 2; ++cb) { cf y[8]; const int wi = cb < NW ? cb : 0;
            if (INV) {
#pragma unroll
                for (int j = 0; j < 8; ++j) x[i][cb][j] = cmul(x[i][cb][j], (cf){w[wi][j].x, -w[wi][j].y}); }
            fft_mfma16<INV>(x[i][cb], y, am);
#pragma unroll
            for (int j = 0; j < 8; ++j) lds[p0[i][cb] + poff<S>(j)] = INV ? y[j] : cmul(y[j], w[wi][j]); }
}
template <int T, int N, int R, class Gen> DI void fft_first_fwd(ldscf lds, int tid, const Gen& gen) {
    constexpr int S = N / R, NB = T / R, NI = NB >= NTHR ? NB / NTHR : 1;
    if (NB < NTHR && tid >= NB) return;
    typename Gen::Pre pre[NI][R]; int bs[NI];
#pragma unroll
    for (int i = 0; i < NI; ++i) { const int u = tid + NTHR * i, b = u / S, k = u % S; bs[i] = b * N + k; FFT_OPAQUE(bs[i]); }
    constexpr bool AHEAD = FFTX_FIRST && sizeof(typename Gen::Pre) <= 4;
#pragma unroll
    for (int m = 0; m < R; ++m) pre[0][m] = gen.pre(bs[0] + m * S);
#pragma unroll
    for (int i = 0; i < NI; ++i) { const int base = bs[i], p0 = pidx(base), k = base % S;
        if (!AHEAD && i > 0) {
#pragma unroll
            for (int m = 0; m < R; ++m) pre[i][m] = gen.pre(base + m * S); }
        cf x[R];
#pragma unroll
        for (int m = 0; m < R; ++m) x[m] = gen(base + m * S, pre[i][m]);
        if (AHEAD && i + 1 < NI) {
#pragma unroll
            for (int m = 0; m < R; ++m) pre[i + 1][m] = gen.pre(bs[i + 1] + m * S); }
        dft_nat<false>(x); twiddle<R, false>(x, (float)k * (1.0f / N));
#pragma unroll
        for (int m = 0; m < R; ++m) lds[p0 + poff<S>(m)] = x[m];
    }
}
template <int R, int NI> DI void fft_last_fwd(ldscf lds, int tid, cf (&res)[NI][R]) {
#pragma unroll
    for (int i = 0; i < NI; ++i) { int p0 = pidx((tid + NTHR * i) * R); FFT_OPAQUE(p0);
#pragma unroll
        for (int m = 0; m < R; ++m) res[i][m] = lds[p0 + m];
        dft_nat<false>(res[i]); }
}
template <int R, int NI> DI void fft_first_inv(ldscf lds, int tid, cf (&res)[NI][R]) {
#pragma unroll
    for (int i = 0; i < NI; ++i) { int p0 = pidx((tid + NTHR * i) * R); FFT_OPAQUE(p0); dft_nat<true>(res[i]);
#pragma unroll
        for (int m = 0; m < R; ++m) lds[p0 + m] = res[i][m]; }
}
template <int T, int N, int R, class Out> DI void fft_last_inv(ldscf lds, int tid, const Out& out) {
    constexpr int S = N / R, NB = T / R, NI = NB >= NTHR ? NB / NTHR : 1;
    if (NB < NTHR && tid >= NB) return;
    typename Out::Pre pre[NI][R]; int bs[NI];
#pragma unroll
    for (int i = 0; i < NI; ++i) { const int u = tid + NTHR * i, b = u / S, k = u % S; bs[i] = b * N + k; FFT_OPAQUE(bs[i]); }
#pragma unroll
    for (int m = 0; m < R; ++m) pre[0][m] = out.pre(bs[0] + m * S);
#pragma unroll
    for (int i = 0; i < NI; ++i) { const int base = bs[i], p0 = pidx(base), k = base % S;
        cf x[R];
#pragma unroll
        for (int m = 0; m < R; ++m) x[m] = lds[p0 + poff<S>(m)];
        twiddle<R, true>(x, (float)k * (1.0f / N)); dft_nat<true>(x);
        if (i + 1 < NI) {
#pragma unroll
            for (int m = 0; m < R; ++m) pre[i + 1][m] = out.pre(bs[i + 1] + m * S); }
#pragma unroll
        for (int m = 0; m < R; ++m) out(base + m * S, x[m], pre[i][m]);
    }
}
template <bool INV> DI void twiddle_h(cf (&y)[8], float rev, int h) {
    asm volatile("" : "+v"(rev));
    const cf w1 = cis_rev(INV ? rev : -rev), w2 = cmul(w1, w1), w3 = cmul(w2, w1), w4 = cmul(w2, w2), w5 = cmul(w4, w1), w6 = cmul(w3, w3), w7 = cmul(w4, w3), w8 = cmul(w4, w4);
    const cf bs = h ? w8 : (cf){1.f, 0.f};
    y[0] = cmul(y[0], bs); y[1] = cmul(y[1], cmul(bs, w1)); y[2] = cmul(y[2], cmul(bs, w2)); y[3] = cmul(y[3], cmul(bs, w3));
    y[4] = cmul(y[4], cmul(bs, w4)); y[5] = cmul(y[5], cmul(bs, w5)); y[6] = cmul(y[6], cmul(bs, w6)); y[7] = cmul(y[7], cmul(bs, w7));
}
template <int T, int N, class Gen> DI void fft_first_fwd_m(ldscf lds, int tid, const Gen& gen) {
    constexpr int S = N / 16, NBLK = 2 * (T / 16 / NTHR);
    static_assert(T / 16 >= NTHR, "one butterfly set per thread at least");
    const int lane = tid & 63, h = lane >> 5, c = lane & 31, wb = tid & ~63;
    bf16x8 am[4]; fft_load_amat(lds, lane, am);
    typename Gen::Pre pre[NBLK][8]; int bs[NBLK];
#pragma unroll
    for (int q = 0; q < NBLK; ++q) { const int u = wb + 32 * (q & 1) + c + NTHR * (q >> 1), b = u / S, k = u % S; bs[q] = b * N + k; FFT_OPAQUE(bs[q]); }
#pragma unroll
    for (int q = 0; q < NBLK; ++q)
#pragma unroll
        for (int j = 0; j < 8; ++j) pre[q][j] = gen.pre(bs[q] + (8 * h + j) * S);
#pragma unroll
    for (int q = 0; q < NBLK; ++q) { const int base = bs[q], k = base % S, p0 = pidx(base) + h * poff<S>(8);
        cf x[8], y[8];
#pragma unroll
        for (int j = 0; j < 8; ++j) x[j] = gen(base + (8 * h + j) * S, pre[q][j]);
        fft_mfma16<false>(x, y, am);
        twiddle_h<false>(y, (float)k * (1.0f / N), h);
#pragma unroll
        for (int j = 0; j < 8; ++j) lds[p0 + poff<S>(j)] = y[j];
    }
}
template <int T, int N, class Out> DI void fft_last_inv_m(ldscf lds, int tid, const Out& out) {
    constexpr int S = N / 16, NBLK = 2 * (T / 16 / NTHR);
    static_assert(T / 16 >= NTHR, "one butterfly set per thread at least");
    const int lane = tid & 63, h = lane >> 5, c = lane & 31, wb = tid & ~63;
    bf16x8 am[4]; fft_load_amat(lds, lane, am);
    constexpr int PD = LAST_PD < NBLK ? LAST_PD : NBLK;
    typename Out::Pre pre[NBLK][8]; int bs[NBLK];
#pragma unroll
    for (int q = 0; q < NBLK; ++q) { const int u = wb + 32 * (q & 1) + c + NTHR * (q >> 1), b = u / S, k = u % S; bs[q] = b * N + k; FFT_OPAQUE(bs[q]); }
#pragma unroll
    for (int q = 0; q < PD; ++q)
#pragma unroll
        for (int j = 0; j < 8; ++j) pre[q][j] = out.pre(bs[q] + (8 * h + j) * S);
#pragma unroll
    for (int q = 0; q < NBLK; ++q) { const int base = bs[q], k = base % S, p0 = pidx(base) + h * poff<S>(8);
        cf x[8], y[8];
#pragma unroll
        for (int j = 0; j < 8; ++j) x[j] = lds[p0 + poff<S>(j)];
        twiddle_h<true>(x, (float)k * (1.0f / N), h);
        fft_mfma16<true>(x, y, am);
        if (q + PD < NBLK) {
#pragma unroll
            for (int j = 0; j < 8; ++j) pre[q + PD][j] = out.pre(bs[q + PD] + (8 * h + j) * S); }
#pragma unroll
        for (int j = 0; j < 8; ++j) out(base + (8 * h + j) * S, y[j], pre[q][j]);
    }
}
struct GenZS { const unsigned* z; int half; typedef unsigned Pre; DI Pre pre(int e) const { return z[e]; }
    DI cf operator()(int e, Pre w) const { const cf v = unpk(w); if (!half) return v; return cmul(v, cis_rev(-(float)e * (1.0f / (2 * LS)))); } };
struct OutOddS { unsigned* scr; struct Pre {}; DI Pre pre(int) const { return Pre{}; } DI void operator()(int e, cf v, Pre) const { const cf r = cmul(v, cis_rev((float)e * (1.0f / (2 * LS)))); scr[e] = pk2(r.x, r.y); } };
struct OutEvenS { const unsigned* scr; unsigned* yc;
    struct Pre { unsigned so; };
    DI Pre pre(int e) const { Pre p; p.so = __hip_atomic_load(scr + e, __ATOMIC_RELAXED, __HIP_MEMORY_SCOPE_AGENT); return p; }
    DI void operator()(int e, cf v, Pre p) const { const cf y = v + unpk(p.so); yc[e] = pk2(y.x, y.y); } };

DI void fft_last_fwd_store(ldscf lds, int tid, unsigned* kfs) {
    for (int i = 0; i < 8; ++i) { int base = 1024 * ((tid >> 6) + 8 * (i >> 2)) + 4 * ((tid & 63) + 64 * (i & 3)); FFT_OPAQUE(base); const int p0 = pidx(base); cf x[4];
        const f32x4 a = *(const LAS f32x4*)(lds + p0), b = *(const LAS f32x4*)(lds + p0 + 2);
        x[0] = (cf){a.x, a.y}; x[1] = (cf){a.z, a.w}; x[2] = (cf){b.x, b.y}; x[3] = (cf){b.z, b.w};
        dft_nat<false>(x);
        v4u kw; kw.x = pk2(x[0].x, x[0].y); kw.y = pk2(x[1].x, x[1].y); kw.z = pk2(x[2].x, x[2].y); kw.w = pk2(x[3].x, x[3].y); *(GAS v4u*)(kfs + base) = kw; }
}
DI void fft_mid_mul(ldscf lds, int tid, const unsigned* kfs) {
    int base0 = 1024 * (tid >> 6) + 4 * (tid & 63); FFT_OPAQUE(base0);
    v4u kw[8];
#pragma unroll
    for (int i = 0; i < 8; ++i) if (FFTX_MID) kw[i] = __builtin_nontemporal_load((const GAS v4u*)(kfs + base0 + 8192 * (i >> 2) + 256 * (i & 3)));
#pragma unroll
    for (int i = 0; i < 8; ++i) { if (!FFTX_MID) kw[i] = __builtin_nontemporal_load((const GAS v4u*)(kfs + base0 + 8192 * (i >> 2) + 256 * (i & 3))); const int p0 = pidx(base0) + (8192 + 512) * (i >> 2) + (256 + 16) * (i & 3); cf x[4];
        const f32x4 a = *(const LAS f32x4*)(lds + p0), b = *(const LAS f32x4*)(lds + p0 + 2);
        x[0] = (cf){a.x, a.y}; x[1] = (cf){a.z, a.w}; x[2] = (cf){b.x, b.y}; x[3] = (cf){b.z, b.w};
        dft_nat<false>(x);
        x[0] = cmul(x[0], unpk(kw[i].x)); x[1] = cmul(x[1], unpk(kw[i].y)); x[2] = cmul(x[2], unpk(kw[i].z)); x[3] = cmul(x[3], unpk(kw[i].w));
#if FFT_PROBE_MID
        for (int m = 0; m < 4; ++m) x[m] = x[m] * FFT_PROBE_SCALE;
#endif
        dft_nat<true>(x);
        *(LAS f32x4*)(lds + p0) = (f32x4){x[0].x, x[0].y, x[1].x, x[1].y}; *(LAS f32x4*)(lds + p0 + 2) = (f32x4){x[2].x, x[2].y, x[3].x, x[3].y}; }
}
DI constexpr int fft_a64_tile(int q) { return q < 6 ? 153088 + 1024 * q : 160768 + 1024 * (q - 6); }
static_assert((TW_OFF + 16 * (64 + 4 + 8)) * 8 + 4096 == 153088 && 153088 + 6 * 1024 <= SCRATCH_BYTES && PTAB_OFF + 27 * 8 <= 160768 && 160768 + 2 * 1024 <= LDS_BYTES, "FFT DFT_64 tile placement");
DI void fft_build_a64(LAS unsigned char* ldsb, int tid) {
    const int q = tid >> 6, l = tid & 63, mat = q >> 2, st = q & 3, r = l & 31, hl = l >> 5, i = 4 * (r >> 3) + (r & 3), ho = (r >> 2) & 1;
    const int f0 = ((i >> 3) << 4) | (ho << 3) | (i & 7);
    float v[8];
#pragma unroll
    for (int jj = 0; jj < 8; ++jj) { const int n = (f0 * (16 * st + 8 * hl + jj)) & 63; const float rev = (float)n * (1.0f / 64.0f); v[jj] = mat ? __builtin_amdgcn_sinf(rev) : __builtin_amdgcn_cosf(rev); }
    v4u o; o.x = pk2(v[0], v[1]); o.y = pk2(v[2], v[3]); o.z = pk2(v[4], v[5]); o.w = pk2(v[6], v[7]);
    const int off = (q < 6 ? 153088 + 1024 * q : 160768 + 1024 * (q - 6)) + l * 16;
    *(LAS v4u*)(ldsb + off) = o;
}
template <bool INV> DI void fft_pack64(const cf (&v)[32], v4u (&br)[4], v4u (&bi)[4]) {
#pragma unroll
    for (int s = 0; s < 4; ++s)
#pragma unroll
        for (int q = 0; q < 4; ++q) { const unsigned re = pk2(v[8 * s + 2 * q].x, v[8 * s + 2 * q + 1].x), im = pk2(v[8 * s + 2 * q].y, v[8 * s + 2 * q + 1].y);
            br[s][q] = INV ? im : re; bi[s][q] = INV ? re : im; }
}
template <bool INV> DI void fft_mm64(const v4u (&br)[4], const v4u (&bi)[4], LAS unsigned char* ldsb, int lane, cf (&v)[32]) {
    f32x16 yr[2], yi[2];
#pragma unroll
    for (int t = 0; t < 2; ++t)
#pragma unroll
        for (int i = 0; i < 16; ++i) { yr[t][i] = 0.f; yi[t][i] = 0.f; }
#pragma unroll
    for (int s = 0; s < 4; ++s) {
        const bf16x8 cT = *(const LAS bf16x8*)(ldsb + fft_a64_tile(s) + lane * 16), sT = *(const LAS bf16x8*)(ldsb + fft_a64_tile(4 + s) + lane * 16);
        v4u xr1, xi1, xn, xn1;
#pragma unroll
        for (int q = 0; q < 4; ++q) { xr1[q] = br[s][q] ^ 0x80000000u; xi1[q] = bi[s][q] ^ 0x80000000u; xn[q] = br[s][q] ^ 0x80008000u; xn1[q] = br[s][q] ^ 0x00008000u; }
        const bf16x8 a_r = __builtin_bit_cast(bf16x8, br[s]), a_i = __builtin_bit_cast(bf16x8, bi[s]), a_n = __builtin_bit_cast(bf16x8, xn), b_r = __builtin_bit_cast(bf16x8, xr1), b_i = __builtin_bit_cast(bf16x8, xi1), b_n = __builtin_bit_cast(bf16x8, xn1);
        yr[0] = __builtin_amdgcn_mfma_f32_32x32x16_bf16(cT, a_r, yr[0], 0, 0, 0); yr[1] = __builtin_amdgcn_mfma_f32_32x32x16_bf16(cT, b_r, yr[1], 0, 0, 0);
        yi[0] = __builtin_amdgcn_mfma_f32_32x32x16_bf16(cT, a_i, yi[0], 0, 0, 0); yi[1] = __builtin_amdgcn_mfma_f32_32x32x16_bf16(cT, b_i, yi[1], 0, 0, 0);
        yr[0] = __builtin_amdgcn_mfma_f32_32x32x16_bf16(sT, a_i, yr[0], 0, 0, 0); yr[1] = __builtin_amdgcn_mfma_f32_32x32x16_bf16(sT, b_i, yr[1], 0, 0, 0);
        yi[0] = __builtin_amdgcn_mfma_f32_32x32x16_bf16(sT, a_n, yi[0], 0, 0, 0); yi[1] = __builtin_amdgcn_mfma_f32_32x32x16_bf16(sT, b_n, yi[1], 0, 0, 0);
    }
#pragma unroll
    for (int t = 0; t < 2; ++t)
#pragma unroll
        for (int i = 0; i < 16; ++i) v[16 * t + i] = INV ? (cf){yi[t][i], yr[t][i]} : (cf){yr[t][i], yi[t][i]};
}
DI int fft_blk64(int tid, int& pb) { const int lane = tid & 63, h = lane >> 5, c = lane & 31, w = tid >> 6; int blk = 16 * (w + 8 * (c >> 4)) + (c & 15); FFT_OPAQUE(blk); pb = blk * 68 + 8 * h; return blk; }
DI void fft_ld64(ldscf lds, int pb, cf (&v)[32]) {
#pragma unroll
    for (int s = 0; s < 4; ++s)
#pragma unroll
        for (int q = 0; q < 4; ++q) { const f32x4 t = *(const LAS f32x4*)(lds + pb + 16 * s + 2 * q); v[8 * s + 2 * q] = (cf){t.x, t.y}; v[8 * s + 2 * q + 1] = (cf){t.z, t.w}; }
}
DI void fft_st64(ldscf lds, int pb, const cf (&v)[32]) {
#pragma unroll
    for (int s = 0; s < 4; ++s)
#pragma unroll
        for (int q = 0; q < 4; ++q) *(LAS f32x4*)(lds + pb + 16 * s + 2 * q) = (f32x4){v[8 * s + 2 * q].x, v[8 * s + 2 * q].y, v[8 * s + 2 * q + 1].x, v[8 * s + 2 * q + 1].y};
}
DI void fft_mid64_kernel(ldscf lds, int tid) {
    int pb; fft_blk64(tid, pb); cf v[32]; v4u br[4], bi[4];
    fft_ld64(lds, pb, v); fft_pack64<false>(v, br, bi); fft_mm64<false>(br, bi, (LAS unsigned char*)lds, tid & 63, v); fft_st64(lds, pb, v);
}
DI void fft_mid64_data(ldscf lds, int tid, const unsigned* kfs) {
    int pb; fft_blk64(tid, pb); cf v[32]; v4u br[4], bi[4];
    fft_ld64(lds, pb, v); fft_pack64<false>(v, br, bi);
    v4u kw[8];
#pragma unroll
    for (int q = 0; q < 8; ++q) kw[q] = __builtin_nontemporal_load((const GAS v4u*)(kfs + (q * NTHR + tid) * 4));
    fft_mm64<false>(br, bi, (LAS unsigned char*)lds, tid & 63, v);
#pragma unroll
    for (int e = 0; e < 32; ++e) v[e] = cmul(v[e], unpk(kw[e >> 2][e & 3]));
    fft_pack64<true>(v, br, bi); fft_mm64<true>(br, bi, (LAS unsigned char*)lds, tid & 63, v); fft_st64(lds, pb, v);
}
DI int fft_rho(int k) { return ((k & 15) << 10) | (((k >> 4) & 15) << 6) | (k >> 8); }
DI int fft_rho_inv(int p) { return (p >> 10) | (((p >> 6) & 15) << 4) | ((p & 63) << 8); }
struct GenK2S { const unsigned* hfp; const unsigned* hbp; int half; float skA, skB;
    struct Pre { unsigned f, b; };
    DI Pre pre(int e) const { Pre p; p.f = hfp[e]; p.b = e ? hbp[LS - e] : 0u; return p; }
    DI cf operator()(int e, Pre p) const { float aA = bf_lo(p.f), aB = bf_hi(p.f); const float bA = bf_lo(p.b), bB = bf_hi(p.b);
        if (e == 0) { aA += skA; aB += skB; }
        if (!half) return (cf){aA + bA, aB + bB};
        return cmul((cf){aA - bA, aB - bB}, cis_rev(-(float)e * (1.0f / (2 * LS)))); } };
DI void fft_r4_inplace(ldscf lds, int tid) {
    for (int i = 0; i < 8; ++i) { int base = 1024 * ((tid >> 6) + 8 * (i >> 2)) + 4 * ((tid & 63) + 64 * (i & 3)); FFT_OPAQUE(base); const int p0 = pidx(base); cf x[4];
        const f32x4 a = *(const LAS f32x4*)(lds + p0), b = *(const LAS f32x4*)(lds + p0 + 2);
        x[0] = (cf){a.x, a.y}; x[1] = (cf){a.z, a.w}; x[2] = (cf){b.x, b.y}; x[3] = (cf){b.z, b.w};
        dft_nat<false>(x);
        *(LAS f32x4*)(lds + p0) = (f32x4){x[0].x, x[0].y, x[1].x, x[1].y}; *(LAS f32x4*)(lds + p0 + 2) = (f32x4){x[2].x, x[2].y, x[3].x, x[3].y}; }
}
DI void fft_kernel_separate(ldscf lds, int tid, int half, unsigned* kfA, unsigned* kfB) {
    int pb; const int blk = fft_blk64(tid, pb), h = (tid >> 5) & 1;
    for (int q = 0; q < 8; ++q) { int base = blk * 64 + 16 * (q >> 1) + 8 * h + 4 * (q & 1); FFT_OPAQUE(base); const int p0 = pidx(base);
        const f32x4 a = *(const LAS f32x4*)(lds + p0), b = *(const LAS f32x4*)(lds + p0 + 2);
        const cf u[4] = {(cf){a.x, a.y}, (cf){a.z, a.w}, (cf){b.x, b.y}, (cf){b.z, b.w}};
        unsigned wa[4], wb[4];
#pragma unroll
        for (int m = 0; m < 4; ++m) { const int k = fft_rho_inv(base + m), kp = half ? (LS - 1 - k) : ((LS - k) & (LS - 1)); cf v = lds[pidx(fft_rho(kp))]; v.y = -v.y;
            const cf ka = (u[m] + v) * 0.5f, dd = u[m] - v; wa[m] = pk2(ka.x, ka.y); wb[m] = pk2(dd.y * 0.5f, -dd.x * 0.5f); }
        *(GAS v4u*)(kfA + (q * NTHR + tid) * 4) = (v4u){wa[0], wa[1], wa[2], wa[3]}; *(GAS v4u*)(kfB + (q * NTHR + tid) * 4) = (v4u){wb[0], wb[1], wb[2], wb[3]}; }
}
struct SampleChan { const unsigned* z; const unsigned* x0; unsigned* yc; float skip; };
DI void fft_unit_sample2(int tid, ldscf A, const unsigned* hfp, const unsigned* hbp, SampleChan cA, SampleChan cB, unsigned* scr) {
    unsigned* const kfA = scr + 2 * LS; unsigned* const kfB = scr + 3 * LS;
#define FFT_WSYNC() asm volatile("s_waitcnt lgkmcnt(0)" ::: "memory")
    for (int half = 1; half >= 0; --half) {
        __syncthreads();
        fft_first_fwd_m<LS, LS>(A, tid, GenK2S{hfp, hbp, half, cA.skip * (1.0f / (2 * LS)), cB.skip * (1.0f / (2 * LS))}); __syncthreads();
        fft_pass_mfma<LS, 1024, false>(A, tid); __syncthreads();
        fft_mid64_kernel(A, tid); __syncthreads();
        fft_kernel_separate(A, tid, half, kfA, kfB);
        for (int ch = 0; ch < 2; ++ch) {
            const SampleChan c = ch ? cB : cA; unsigned* const uo = scr + ch * LS; const unsigned* const kfs = ch ? kfB : kfA;
            __syncthreads();
            fft_first_fwd_m<LS, LS>(A, tid, GenZS{c.z, half}); __syncthreads();
#if FFT_PROBE_FIRST
            fft_first_fwd_m<LS, LS>(A, tid, GenZS{c.z, half}); __syncthreads();
#endif
            fft_pass_mfma<LS, 1024, false>(A, tid); __syncthreads();
            fft_mid64_data(A, tid, kfs); __syncthreads();
            fft_pass_mfma<LS, 1024, true>(A, tid); __syncthreads();
            if (half) fft_last_inv_m<LS, LS>(A, tid, OutOddS{uo});
            else fft_last_inv_m<LS, LS>(A, tid, OutEvenS{uo, c.yc});
#if FFT_PROBE_LAST
            if (half) { if (FFT_PROBE_LAST != 3) fft_last_inv<LS, LS, 16>(A, tid, OutOddS{uo}); }
            else if (FFT_PROBE_LAST != 2) fft_last_inv<LS, LS, 16>(A, tid, OutEvenS{uo, c.yc});
#endif
        }
    }
}
struct GenKP2 { const unsigned* hfp; const unsigned* hbp; float sk0, sk1; struct Pre { unsigned f, b; };
    DI Pre pre(int e) const { const int j = e & (LP - 1); Pre p; p.f = hfp[j]; p.b = j ? hbp[LP - j] : 0u; return p; }
    DI cf operator()(int e, Pre p) const { const int kidx = e >> 11, half = kidx & 1, ch = kidx >> 1, j = e & (LP - 1); float A = ch ? bf_hi(p.f) : bf_lo(p.f); const float B = ch ? bf_hi(p.b) : bf_lo(p.b);
        if (j == 0) A += ch ? sk1 : sk0;
        if (!half) return (cf){A + B, 0.f}; return (A - B) * cis_rev(-(float)j * (1.0f / (2 * LP))); } };
struct GenZP2 { const unsigned* z; typedef unsigned Pre;
    DI Pre pre(int e) const { const int f = e >> 11, ch = (f >> 1) & 1, pair = f >> 2, j = e & (LP - 1); return z[(size_t)ch * PPOS + pair * LP + j]; }
    DI cf operator()(int e, Pre w) const { const int half = (e >> 11) & 1, j = e & (LP - 1); const cf v = unpk(w); if (!half) return v; return cmul(v, cis_rev(-(float)j * (1.0f / (2 * LP)))); } };
DI void fft_unit_prompt2(int tid, ldscf A, const unsigned* hf, const unsigned* hb, const unsigned* z, const unsigned* x0, float skip0, float skip1, unsigned* yc) {
    cf kf[2][8], d[4][8];
    __syncthreads();
    fft_first_fwd_m<4 * LP, LP>(A, tid, GenKP2{hf, hb, skip0 * (1.0f / (2 * LP)), skip1 * (1.0f / (2 * LP))}); __syncthreads();
    fft_pass_mfma<4 * LP, 128, false>(A, tid); __syncthreads();
    fft_last_fwd<8, 2>(A, tid, kf); __syncthreads();
    fft_first_fwd_m<8 * LP, LP>(A, tid, GenZP2{z}); __syncthreads();
    fft_pass_mfma<8 * LP, 128, false>(A, tid); __syncthreads();
    fft_last_fwd<8, 4>(A, tid, d);
#pragma unroll
    for (int i = 0; i < 4; ++i)
#pragma unroll
        for (int m = 0; m < 8; ++m) d[i][m] = cmul(d[i][m], kf[i & 1][m]);
    fft_first_inv<8, 4>(A, tid, d); __syncthreads();
    fft_pass_mfma<8 * LP, 128, true>(A, tid); __syncthreads();
    fft_pass_lds<8 * LP, LP, 16, true>(A, tid); __syncthreads();
#if FFTX_PROMPT
    constexpr int PB_ = FFTX_PROMPT;
#pragma unroll 1
    for (int qq = 0; qq < 16 / PB_; ++qq) { int tq = tid + NTHR * PB_ * qq; FFT_OPAQUE(tq);
#pragma unroll
        for (int q = 0; q < PB_; ++q) { const int idx = tq + NTHR * q, ch = idx >> 12, pair = (idx >> 11) & 1, t = idx & (LP - 1), fe = 2 * ch + 4 * pair;
            const cf ue = A[pidx(fe * LP + t)], uo = A[pidx((fe + 1) * LP + t)];
            const size_t gi = (size_t)ch * PPOS + pair * LP + t;
            const cf y = (ue + cmul(uo, cis_rev((float)t * (1.0f / (2 * LP)))));
            yc[gi] = pk2(y.x, y.y); }
    }
#else
    for (int idx = tid; idx < 4 * LP; idx += NTHR) {
        const int ch = idx >> 12, pair = (idx >> 11) & 1, t = idx & (LP - 1), fe = 2 * ch + 4 * pair;
        const cf ue = A[pidx(fe * LP + t)], uo = A[pidx((fe + 1) * LP + t)];
        const size_t gi = (size_t)ch * PPOS + pair * LP + t;
        const cf y = (ue + cmul(uo, cis_rev((float)t * (1.0f / (2 * LP)))));
        yc[gi] = pk2(y.x, y.y);
    }
#endif
}
DI void ph_fft(const Ctx& C, unsigned char* lds_generic, const unsigned* HT, const unsigned* ZC, const unsigned* X0C, unsigned* YC, const float* skipv  , unsigned* scr_all, int ch) {
    ldscf A = (ldscf)lds_generic;
    unsigned* scr = scr_all + (size_t)blockIdx.x * (4 * LS);
    for (int e = C.tid; e < 16 * (64 + 4 + 8); e += NTHR) {
        int m, k, n; if (e < 1024) { m = e >> 6; k = e & 63; n = 1024; } else if (e < 1024 + 64) { m = (e - 1024) >> 2; k = e & 3; n = 64; } else { m = (e - 1088) >> 3; k = (e - 1088) & 7; n = 128; }
        A[TW_OFF + e] = cis_rev(-(float)(k * m) / (float)n); }
    fft_build_amat(A, C.tid);
    fft_build_a64((LAS unsigned char*)lds_generic, C.tid);
    __syncthreads();
    for (int un = C.vcu; un < CCH; un += C.G) {
        const int cl = 2 * (un < CCH / 2 ? un : un - CCH / 2);
        const unsigned* hf = HT + (size_t)cl * NPOS; const unsigned* hb = hf + NPOS;
        if (un < CCH / 2) {
            const size_t o0 = (size_t)cl * PPOS + 2 * LP, o1 = o0 + PPOS;
            for (int rp_ = 0; rp_ < FFT_REP_S; ++rp_) fft_unit_sample2(C.tid, A, hf + LP, hb + LP, SampleChan{ZC + o0, X0C + o0, YC + o0, skipv[ch * CCH + cl]}, SampleChan{ZC + o1, X0C + o1, YC + o1, skipv[ch * CCH + cl + 1]}, scr);
        } else for (int rp_ = 0; rp_ < FFT_REP_P; ++rp_) fft_unit_prompt2(C.tid, A, hf, hb, ZC + (size_t)cl * PPOS, X0C + (size_t)cl * PPOS, skipv[ch * CCH + cl], skipv[ch * CCH + cl + 1], YC + (size_t)cl * PPOS);
    }
    __syncthreads();
}

#ifndef REP_G
#define REP_G 1
#endif
#ifndef REP_E
#define REP_E 1
#endif
#ifndef REP_A
#define REP_A 1
#endif
#ifndef REP_R
#define REP_R 1
#endif
#ifndef REP_N
#define REP_N REP_E
#endif
#ifndef REP_F
#define REP_F REP_E
#endif
#ifndef REP_H
#define REP_H REP_E
#endif
#ifndef MK_P2_SPLIT
#define MK_P2_SPLIT 0
#endif
#ifndef XB_EXTRA
#define XB_EXTRA 0
#endif
#ifndef REP_FH
#define REP_FH 1
#endif
#ifndef REP_HG
#define REP_HG 1
#endif
#ifndef REP_HF
#define REP_HF 1
#endif
#ifndef REP_4
#define REP_4 REP_E
#endif
#ifndef MK_LAUNCH_PER_STEP
#define MK_LAUNCH_PER_STEP 0
#endif
struct Args { const float* in[25]; float* out; unsigned char* ws; int step_lo, step_hi; };
constexpr int NSTEPS = (DEPTH / 2) * ((1 + 3 * NHC + 1 + NMLPC + 1) + (1 + 4 * NCH + 1 + NMLPC + 1));

#ifndef MK_LB
#define MK_LB 2
#endif
#ifndef MK_LBT
#define MK_LBT NTHR
#endif
__global__ void __launch_bounds__(MK_LBT, MK_LB) mega_fwd(Args args) {
    extern __shared__ __attribute__((aligned(16))) unsigned char lds[];
    Ctx C0;
    C0.tid = threadIdx.x; C0.lane = C0.tid & 63; C0.wave = __builtin_amdgcn_readfirstlane(C0.tid >> 6);
    C0.G = gridDim.x; { const int bx = blockIdx.x; C0.vcu = (C0.G % 8 == 0) ? (bx % 8) * (C0.G / 8) + bx / 8 : bx; }
    C0.gw = C0.vcu * NWAVES + C0.wave; C0.NGW = C0.G * NWAVES;
    LAS unsigned char* ldsl = (LAS unsigned char*)lds;
    volatile LAS unsigned* MISC = (volatile LAS unsigned*)(ldsl + MISC_OFF);
    for (int u = C0.tid; u < (LDS_BYTES - LDSCTL_OFF) / 4; u += NTHR) ((LAS unsigned*)(ldsl + LDSCTL_OFF))[u] = 0u;
    __syncthreads();
    LAS unsigned long long* const PT = (LAS unsigned long long*)(ldsl + PTAB_OFF);
    if (C0.tid == 0) {
#pragma unroll
        for (int i = 0; i < 25; ++i) PT[i] = (unsigned long long)args.in[i];
        PT[25] = (unsigned long long)args.out; PT[26] = (unsigned long long)args.ws; }
    __syncthreads();
#define PTR(i) ptab_get(PT, (i))
#define IN(i) ((const float*)(const GAS float*)PTR(i))
#define OUTP ((float*)(GAS float*)PTR(25))
#define WSP ((unsigned char*)(GAS unsigned char*)PTR(26))
    XcdBarrier bar; bar.pt = PT; bar.x = 0; bar.st = nullptr;
    if (!MK_LAUNCH_PER_STEP) bar = xcd_barrier_post(PT, MISC + 8);
    const int lo = args.step_lo, hi = args.step_hi;
    int step = 0;
#define PH_BEGIN if (step >= lo && step < hi) { Ctx C = C0; { int t_ = threadIdx.x; asm volatile("" : "+v"(t_)); C.tid = t_; C.lane = t_ & 63; C.wave = __builtin_amdgcn_readfirstlane(t_ >> 6); asm volatile("" : "+s"(C.G), "+s"(C.vcu)); C.NGW = C.G * NWAVES; C.gw = C.vcu * NWAVES + C.wave; } \
    LAS float* const cscr = (LAS float*)ldsl + C.wave * (64 * 65);
#define PH_END } { ++step; if (!MK_LAUNCH_PER_STEP && step > lo && step < hi) xcd_barrier(bar); }

#define XN ((bf16*)(WSP + WS_XN))
#define AO ((bf16*)(WSP + WS_AO))
#define WQKV ((bf16*)(WSP + WS_WB + WB_QKV))
#define WOUT ((bf16*)(WSP + WS_WB + WB_OUT))
#define W1T ((bf16*)(WSP + WS_WB + WB_W1))
#define W2T ((bf16*)(WSP + WS_WB + WB_W2))
#define BIG (WSP + WS_BIG)
#define H3 ((float*)(WSP + WS_H3))
#define LSE ((float*)(WSP + WS_LSE))
#define BIASP ((float*)(WSP + WS_BIASP))
#define SSA ((float*)(WSP + WS_SSA))
#define SSB ((float*)(WSP + WS_SSB))
#define out OUTP
#define ws WSP

    for (int layer = 0; layer < DEPTH; ++layer) {
        const int j = layer >> 1; const bool attn = (layer & 1) == 0;

        PH_BEGIN
          for (int rep_ = 0; rep_ < REP_N; ++rep_) {
            int ib = 0;
            if (attn) { convert_matrix<1>(C, cscr, IN(4) + (size_t)j * D * QKVW, D, QKVW, QKVW, WQKV, ib, IN(2) + (size_t)layer * D); convert_matrix<0>(C, cscr, IN(7) + (size_t)j * D * D, D, D, D, WOUT, ib, nullptr); }
            else { convert_matrix<2>(C, cscr, IN(8) + (size_t)j * D * 3 * D, D, 3 * D, 3 * D, WQKV, ib, IN(2) + (size_t)layer * D); convert_matrix<0>(C, cscr, IN(21) + (size_t)j * D * D, D, D, D, WOUT, ib, nullptr); }
            convert_matrix<0>(C, cscr, IN(23) + (size_t)layer * D * DFF, D, DFF, DFF, W1T, ib, IN(3) + (size_t)layer * D);
            convert_matrix<0>(C, cscr, IN(24) + (size_t)layer * DFF * D, DFF, D, D, W2T, ib, nullptr);
            if (layer == 0) ph_x0(C, IN(0), IN(1), XN, SSB);
            if (!attn) {
                for (int r3_ = 0; r3_ < REP_FH; ++r3_) ph_filter_hidden(C, IN(12) + (size_t)j * 33 * 64, IN(13) + j * 64, IN(14) + (size_t)j * 4096, IN(15) + j * 64, IN(16) + (size_t)j * 4096, IN(17) + j * 64, IN(18) + j * 64, H3);
                for (int n = C.gw * 64 + C.lane; n < 3 * D; n += C.NGW * 64) { const int n0 = n & ~31; BIASP[n] = IN(9)[(size_t)j * 3 * D + map_src_col<2>(n0) + (n & 31)]; }
            }
          }
        PH_END
        for (int chunk = 0; chunk < (attn ? NHC : NCH); ++chunk) {
            PH_BEGIN
              for (int rep_ = 0; rep_ < REP_G; ++rep_) {
                const int Nc = attn ? QCW : UCW;
                pg8::Gemm g{XN, WQKV + (size_t)chunk * Nc * D, M, Nc, D}; pg8::NormOrder S; S.init(M, Nc, C.G, (int)blockIdx.x); S.ss = SSB; S.tbl = ldsl + RING_BYTES;
                pg8::EpiBf16<0> E{(bf16*)(BIG + BIG_QKV), Nc, attn ? nullptr : BIASP + chunk * UCW, ldsl + RING_BYTES, attn ? HC : 0, IN(5) + (size_t)j * 3 * HD, IN(6) + (size_t)j * 3 * HD, (LAS float*)(ldsl + RING_BYTES + 20480), MP, LP - 1, LS - 1};
                pg8::gemm_phase<pg8::EpiBf16<0>, pg8::NormOrder, true, true>(ldsl, g, S, E);
              }
            PH_END
            if (!attn) {
            PH_BEGIN
                { Ctx Ch = C; bool do_gate = true, do_fgen = true;
                  if (MK_P2_SPLIT && (C.G & 1) == 0) { Ch.G = C.G >> 1; Ch.vcu = C.vcu >> 1; Ch.gw = Ch.vcu * NWAVES + C.wave; Ch.NGW = Ch.G * NWAVES; do_gate = (C.vcu & 1) == 0; do_fgen = !do_gate; }
                  if (do_gate) ph_gate(Ch, lds, (const bf16*)(BIG + BIG_U), IN(10) + (size_t)j * 9 * D, IN(11) + (size_t)j * 3 * D, (unsigned*)(BIG + BIG_ZC), (unsigned*)(BIG + BIG_X0C), chunk);
                  if (do_fgen) ph_filter_gen(Ch, lds, H3, IN(19) + (size_t)j * 64 * 2 * D, (unsigned*)(BIG + BIG_HT), chunk); }
            PH_END
            }
            PH_BEGIN
                if (attn) for (int rep_ = 0; rep_ < REP_A; ++rep_) ph_attn(C, (const bf16*)(BIG + BIG_QKV), (bf16*)(BIG + BIG_OG), LSE, lds);
                else for (int rep_ = 0; rep_ < REP_F; ++rep_) ph_fft(C, lds, (const unsigned*)(BIG + BIG_HT), (const unsigned*)(BIG + BIG_ZC), (const unsigned*)(BIG + BIG_X0C), (unsigned*)(BIG + BIG_YC), IN(20) + (size_t)j * D, (unsigned*)(ws + WS_FSCR), chunk);
            PH_END
            PH_BEGIN
              for (int rep_ = 0; rep_ < REP_4; ++rep_) {
                if (attn) ph_combine(C, (const bf16*)(BIG + BIG_OG), LSE, AO, chunk);
                else ph_ytrans(C, lds, (const unsigned*)(BIG + BIG_YC), (const bf16*)(BIG + BIG_U), IN(10) + (size_t)j * 9 * D, IN(11) + (size_t)j * 3 * D, AO, chunk);
              }
            PH_END
        }
        PH_BEGIN
          for (int rep_ = REP_R - 1; rep_ >= 0; --rep_) {
            pg8::Gemm g{AO, WOUT, M, D, D}; pg8::StaticOrder S; S.init(M, D, C.G, (int)blockIdx.x);
            pg8::EpiResF32 E{rep_ ? (float*)(BIG) : out, D, attn ? nullptr : IN(22) + (size_t)j * D, rep_ ? (bf16*)(BIG + 352 * MiB) : XN, rep_ ? (float*)(BIG + 520 * MiB) : SSA, (LAS float*)(ldsl + RING_BYTES + 16384), layer == 0 ? IN(0) : (const float*)out, layer == 0 ? IN(1) : (const float*)(out + (size_t)MP * D), MP};
            pg8::gemm_phase<pg8::EpiResF32, pg8::StaticOrder, true, true>(ldsl, g, S, E);
          }
        PH_END
        for (int tc = 0; tc <= NMLPC; ++tc) {
            PH_BEGIN
                if (tc >= 1) {
                    const int pc = tc - 1;
                  for (int rep_ = REP_R - 1; rep_ >= 0; --rep_) {
                    pg8::Gemm g{(const bf16*)(BIG + BIG_H + (size_t)(pc & 1) * H_BYTES), W2T, MLPC, D, DFF}; pg8::StaticOrder S; S.init(MLPC, D, C.G, (int)blockIdx.x);
                    pg8::EpiResF32 E{rep_ ? (float*)(BIG + 256 * MiB) : out + (size_t)pc * MLPC * D, D, nullptr, rep_ ? (bf16*)(BIG + 320 * MiB) : XN + (size_t)pc * MLPC * D, rep_ ? (float*)(BIG + 352 * MiB) : SSB + (size_t)pc * MLPC * 8, (LAS float*)(ldsl + RING_BYTES + 16384), out + (size_t)pc * MLPC * D, out + (size_t)pc * MLPC * D, 0};
                    pg8::gemm_phase<pg8::EpiResF32, pg8::StaticOrder, true, true>(ldsl, g, S, E);
                  }
                }
                if (tc < NMLPC) {
                  for (int rep_ = 0; rep_ < REP_G; ++rep_) {
                    pg8::Gemm g{XN + (size_t)tc * MLPC * D, W1T, MLPC, DFF, D}; pg8::NormOrder S; S.init(MLPC, DFF, C.G, (int)blockIdx.x); S.ss = SSA + (size_t)tc * MLPC * 8; S.tbl = ldsl + RING_BYTES;
                    pg8::EpiBf16<3> E{(bf16*)(BIG + BIG_H + (size_t)(tc & 1) * H_BYTES), DFF, nullptr, ldsl + RING_BYTES, 0, nullptr, nullptr, nullptr, 0, 0, 0};
                    pg8::gemm_phase<pg8::EpiBf16<3>, pg8::NormOrder, true, true>(ldsl, g, S, E);
                  }
                }
            PH_END
        }
#if XB_EXTRA
#pragma unroll 1
        for (int e_ = 0; e_ < XB_EXTRA; ++e_) xcd_barrier(bar);
#endif
    }
#undef out
#undef ws
#undef PH_BEGIN
#undef PH_END
}

extern "C" void kernel_launch(void* const* d_in, const int* in_sizes, int n_in, void* d_out, int out_size, void* d_ws, size_t ws_size, hipStream_t stream) {
    static int grid = 0;
    if (grid == 0) {
        if (n_in != 25 || out_size != M * D || ws_size < WS_END) { fprintf(stderr, "kernel_launch: unexpected problem (n_in %d, out %d, ws %zu < %zu)\n", n_in, out_size, ws_size, (size_t)WS_END); grid = -1; return; }
        int dev = 0, cus = 0, per_cu = 0;
        if (hipGetDevice(&dev) != hipSuccess || hipDeviceGetAttribute(&cus, hipDeviceAttributeMultiprocessorCount, dev) != hipSuccess) { grid = -1; return; }
        if (hipFuncSetAttribute((const void*)mega_fwd, hipFuncAttributeMaxDynamicSharedMemorySize, LDS_BYTES) != hipSuccess) { fprintf(stderr, "kernel_launch: hipFuncSetAttribute failed\n"); grid = -1; return; }
        if (hipOccupancyMaxActiveBlocksPerMultiprocessor(&per_cu, (const void*)mega_fwd, NTHR, LDS_BYTES) != hipSuccess || per_cu < 1) fprintf(stderr, "kernel_launch: occupancy query reports %d\n", per_cu);
        (void)hipGetLastError();
        grid = cus > 256 ? 256 : cus;
    }
    if (grid < 0) return;
    if (hipMemsetAsync((char*)d_ws + WS_CTL, 0, CTL_ZERO_BYTES, stream) != hipSuccess) return;
    Args a{};
    for (int i = 0; i < 25; ++i) a.in[i] = (const float*)d_in[i];
    a.out = (float*)d_out; a.ws = (unsigned char*)d_ws;
#if MK_LAUNCH_PER_STEP
    for (int s = 0; s < NSTEPS; ++s) { a.step_lo = s; a.step_hi = s + 1; hipLaunchKernelGGL(mega_fwd, dim3(grid), dim3(NTHR), LDS_BYTES, stream, a); }
#else
    a.step_lo = 0; a.step_hi = NSTEPS;
    hipLaunchKernelGGL(mega_fwd, dim3(grid), dim3(NTHR), LDS_BYTES, stream, a);
#endif
    const hipError_t le = hipPeekAtLastError();
    if (le != hipSuccess) fprintf(stderr, "kernel_launch: launch failed: %s\n", hipGetErrorName(le));
}
```
